# Optimizing an MI355X kernel written in HIP

```python
import math
import jax
import jax.numpy as jnp
from jax import lax
import numpy as np

D_MODEL = 1024
BATCH = 32
SEQ = 256
DEPTH = 1
DEC_BATCH = 4
DEC_SEQ = 1024
PAST_LEN = 256

GRID_W = 64
H_A = D_MODEL // 128
DK_A = 64
DV_A = 64
H_B = D_MODEL // 256
DQK_B = 64
DV_B = 128
A_QK = H_A * DK_A
A_V = H_A * DV_A
B_QK = H_B * 2 * DQK_B
B_V = H_B * DV_B
MIX_WIDTH = A_V + B_V
IN_SIZES = (A_QK, A_QK, A_V, A_V, 2 * H_A, 2 * H_A, B_QK, B_QK, B_V)
IN_COLS = 2 * A_QK + 2 * A_V + 4 * H_A + 2 * B_QK + B_V
CONV_K = 5
CHUNK = 64
Q_BLOCK = 128
D_FF = ((8 * D_MODEL // 3 + 127) // 128) * 128
N_MOD = 9
ROPE_THETA = 10000.0
ROPE_AXIS_DIM = DQK_B // 2
ROPE_PAIRS = ROPE_AXIS_DIM // 2
EPS = 1e-6

kernel_name = 'hybrid_deltanet_diffattn_prefix_dit_step'


def rmsnorm(x, gain):
    xf = x.astype(jnp.float32)
    y = xf * lax.rsqrt(jnp.mean(xf * xf, axis=-1, keepdims=True) + EPS)
    return (y * gain.astype(jnp.float32)).astype(x.dtype)


def l2norm(x):
    xf = x.astype(jnp.float32)
    return xf * lax.rsqrt(jnp.sum(xf * xf, axis=-1, keepdims=True) + EPS)


def adaln(cond, w_ada, b_ada):
    m = jax.nn.silu(cond) @ w_ada + b_ada
    return m.reshape(cond.shape[:-1] + (1, N_MOD, D_MODEL))


def modulated_norm(x, gain, shift, scale):
    return rmsnorm(x, gain) * (1 + scale) + shift


def swiglu(h, w_in, w_out):
    gate, up = jnp.split(h @ w_in, 2, axis=-1)
    return (jax.nn.silu(gate) * up) @ w_out


def split_cols(z, sizes):
    out, start = [], 0
    for s in sizes:
        out.append(z[..., start:start + s])
        start += s
    return out


def centred_dwconv(x, w):
    return lax.conv_general_dilated(
        x, w[:, None, :].astype(x.dtype), window_strides=(1,),
        padding=[(CONV_K // 2, CONV_K // 2)],
        dimension_numbers=('NWC', 'WIO', 'NWC'), feature_group_count=x.shape[-1])


def axial_rope(x):
    length = x.shape[1]
    n_rows = length // GRID_W
    pos_row = jnp.repeat(jnp.arange(n_rows), GRID_W).astype(jnp.float32)
    pos_col = jnp.tile(jnp.arange(GRID_W), n_rows).astype(jnp.float32)
    inv = ROPE_THETA ** (-jnp.arange(ROPE_PAIRS, dtype=jnp.float32) / ROPE_PAIRS)

    def rot(v, pos):
        ang = pos[:, None] * inv
        cos = jnp.cos(ang)[None, :, None, None, :]
        sin = jnp.sin(ang)[None, :, None, None, :]
        v1, v2 = v[..., :ROPE_PAIRS], v[..., ROPE_PAIRS:]
        return jnp.concatenate([v1 * cos - v2 * sin, v2 * cos + v1 * sin], axis=-1)

    xf = x.astype(jnp.float32)
    out = jnp.concatenate([rot(xf[..., :ROPE_AXIS_DIM], pos_row), rot(xf[..., ROPE_AXIS_DIM:], pos_col)], axis=-1)
    return out.astype(x.dtype)


def diff_attention(q, k, v, lam):
    bsz, lq = q.shape[0], q.shape[1]
    nb = lq // Q_BLOCK
    qb = jnp.moveaxis(q.reshape((bsz, nb, Q_BLOCK) + q.shape[2:]), 1, 0)
    scale = DQK_B ** -0.5

    def one_block(qblk):
        s = jnp.einsum('bqhmd,bkhmd->bhmqk', qblk, k).astype(jnp.float32) * scale
        p = jax.nn.softmax(s, axis=-1)
        a = p[:, :, 0] - lam * p[:, :, 1]
        return jnp.einsum('bhqk,bkhe->bqhe', a.astype(v.dtype), v)

    o = lax.map(one_block, qb)
    return jnp.moveaxis(o, 0, 1).reshape((bsz, lq) + o.shape[3:])


def gated_delta_chunked(q, k, v, g, beta, s0):
    bsz, length, nh, dk = q.shape
    dv = v.shape[-1]
    n = length // CHUNK

    def blocks(t):
        t = t.reshape((bsz, n, CHUNK, nh) + t.shape[3:])
        return jnp.moveaxis(t, 3, 1)

    qc = blocks(q) * (dk ** -0.5)
    kc = blocks(k)
    vc = blocks(v)
    gc = jnp.cumsum(blocks(g), axis=-1)
    bc = blocks(beta)
    idx = jnp.arange(CHUNK)
    incl = idx[:, None] >= idx[None, :]
    strict = idx[:, None] > idx[None, :]
    decay = jnp.exp(jnp.where(incl, gc[..., :, None] - gc[..., None, :], -jnp.inf))
    kk = jnp.einsum('bhncd,bhnsd->bhncs', kc, kc)
    a_mat = jnp.where(strict, bc[..., :, None] * kk * decay, 0.0) + jnp.eye(CHUNK, dtype=jnp.float32)
    rhs = jnp.concatenate([bc[..., None] * vc, (bc * jnp.exp(gc))[..., None] * kc], axis=-1)
    sol = lax.linalg.triangular_solve(a_mat, rhs, left_side=True, lower=True, unit_diagonal=True)
    u0, w = sol[..., :dv], sol[..., dv:]
    qk = jnp.where(incl, jnp.einsum('bhncd,bhnsd->bhncs', qc, kc) * decay, 0.0)
    qg = qc * jnp.exp(gc)[..., None]
    kg = kc * jnp.exp(gc[..., -1:] - gc)[..., None]
    glast = jnp.exp(gc[..., -1])
    xs = (jnp.moveaxis(qg, 2, 0), jnp.moveaxis(kg, 2, 0), jnp.moveaxis(u0, 2, 0),
          jnp.moveaxis(w, 2, 0), jnp.moveaxis(qk, 2, 0), jnp.moveaxis(glast, 2, 0))

    def step(state, inp):
        qg_n, kg_n, u0_n, w_n, qk_n, gl_n = inp
        u = u0_n - jnp.einsum('bhcd,bhde->bhce', w_n, state)
        o = jnp.einsum('bhcd,bhde->bhce', qg_n, state) + jnp.einsum('bhcs,bhse->bhce', qk_n, u)
        state = state * gl_n[..., None, None] + jnp.einsum('bhcd,bhce->bhde', kg_n, u)
        return state, o

    s_final, o = lax.scan(step, s0, xs)
    o = jnp.moveaxis(jnp.moveaxis(o, 0, 2), 1, 3).reshape(bsz, length, nh, dv)
    return o, s_final


def mixer(h, lp, lam_init, ctx_k, ctx_v, s0):
    bsz, length, _ = h.shape
    aq, ak, av, az, a_dec, a_beta, bq, bk, bv = split_cols(h @ lp['w_in'], IN_SIZES)

    qkv = jax.nn.silu(centred_dwconv(jnp.concatenate([aq, ak, av], axis=-1), lp['conv_w']))
    aq, ak, av = jnp.split(qkv, [A_QK, 2 * A_QK], axis=-1)
    qa = l2norm(aq.reshape(bsz, length, H_A, DK_A))
    ka = l2norm(ak.reshape(bsz, length, H_A, DK_A))
    va = av.reshape(bsz, length, H_A, DV_A).astype(jnp.float32)
    a_dec = a_dec.reshape(bsz, length, 2, H_A).astype(jnp.float32)
    g = -jnp.exp(lp['a_log'].astype(jnp.float32)) * jax.nn.softplus(a_dec + lp['dt_bias'].astype(jnp.float32))
    beta = jax.nn.sigmoid(a_beta.reshape(bsz, length, 2, H_A).astype(jnp.float32))
    if s0 is None:
        s0 = jnp.zeros((bsz, 2, H_A, DK_A, DV_A), jnp.float32)
    s0 = s0.astype(jnp.float32)
    o_f, s_f = gated_delta_chunked(qa, ka, va, g[:, :, 0], beta[:, :, 0], s0[:, 0])
    o_b, s_b = gated_delta_chunked(qa[:, ::-1], ka[:, ::-1], va[:, ::-1],
                                   g[:, ::-1, 1], beta[:, ::-1, 1], s0[:, 1])
    o_a = rmsnorm(o_f + o_b[:, ::-1], lp['delta_norm'])
    o_a = (o_a * jax.nn.silu(az.reshape(bsz, length, H_A, DV_A).astype(jnp.float32))).astype(h.dtype)
    state = jnp.stack([s_f, s_b], axis=1).astype(h.dtype)

    qb = bq.reshape(bsz, length, H_B, 2, DQK_B)
    kb = bk.reshape(bsz, length, H_B, 2, DQK_B)
    vb = bv.reshape(bsz, length, H_B, DV_B)
    f32 = jnp.float32
    lam = (jnp.exp(jnp.sum(lp['lambda_q1'].astype(f32) * lp['lambda_k1'].astype(f32)))
           - jnp.exp(jnp.sum(lp['lambda_q2'].astype(f32) * lp['lambda_k2'].astype(f32))) + lam_init)
    if ctx_k is None:
        o_b_att = diff_attention(qb, kb, vb, lam)
    else:
        keys = jnp.concatenate([ctx_k.astype(kb.dtype), axial_rope(kb)], axis=1)
        vals = jnp.concatenate([ctx_v.astype(vb.dtype), vb], axis=1)
        o_b_att = diff_attention(axial_rope(qb), keys, vals, lam)
    o_b_att = rmsnorm(o_b_att, lp['diff_norm']) * (1 - lam_init)

    y = jnp.concatenate([o_a.reshape(bsz, length, A_V), o_b_att.reshape(bsz, length, B_V)], axis=-1) @ lp['w_out']
    return y, (kb, vb, state)


def trunk_layer(x, mod, lp, lam_init, ctx_k, ctx_v, s0):
    x = x + 0.5 * mod[..., 2, :] * swiglu(modulated_norm(x, lp['norm_ffn1'], mod[..., 0, :], mod[..., 1, :]),
                                          lp['w_ffn1_in'], lp['w_ffn1_out'])
    h = modulated_norm(x, lp['norm_mix'], mod[..., 3, :], mod[..., 4, :])
    y, ctx_tensors = mixer(h, lp, lam_init, ctx_k, ctx_v, s0)
    x = x + mod[..., 5, :] * y
    x = x + 0.5 * mod[..., 8, :] * swiglu(modulated_norm(x, lp['norm_ffn2'], mod[..., 6, :], mod[..., 7, :]),
                                          lp['w_ffn2_in'], lp['w_ffn2_out'])
    return x, ctx_tensors


def setup_inputs(seed: int = 0) -> dict:
    key = jax.random.key(seed)
    ks = jax.random.split(key, 28)
    f32 = jnp.float32

    def nrm(k, shape, scale=1.0):
        return jax.random.normal(k, shape, f32) * scale

    def gain(k, shape):
        return 1.0 + 0.02 * jax.random.normal(k, shape, f32)

    dt = jnp.exp(jax.random.uniform(ks[16], (DEPTH, 2, H_A), f32, math.log(1e-3), math.log(1e-1)))
    return {
        'x_prompt': nrm(ks[0], (BATCH, SEQ, D_MODEL)),
        'x_sample': nrm(ks[1], (DEC_BATCH, DEC_SEQ, D_MODEL)),
        'cache_diff_k': nrm(ks[2], (DEC_BATCH, DEPTH, PAST_LEN, H_B, 2, DQK_B)),
        'cache_diff_v': nrm(ks[3], (DEC_BATCH, DEPTH, PAST_LEN, H_B, DV_B)),
        'state_delta': nrm(ks[4], (DEC_BATCH, DEPTH, 2, H_A, DK_A, DV_A), 0.1),
        'c': nrm(ks[5], (DEC_BATCH, D_MODEL)),
        'c_ctx': nrm(ks[6], (D_MODEL,)),
        'w_ada': nrm(ks[7], (DEPTH, D_MODEL, N_MOD * D_MODEL), 0.5 * D_MODEL ** -0.5),
        'b_ada': nrm(ks[8], (DEPTH, N_MOD * D_MODEL), 0.02),
        'norm_ffn1': gain(ks[9], (DEPTH, D_MODEL)),
        'w_ffn1_in': nrm(ks[10], (DEPTH, D_MODEL, 2 * D_FF), D_MODEL ** -0.5),
        'w_ffn1_out': nrm(ks[11], (DEPTH, D_FF, D_MODEL), D_FF ** -0.5),
        'norm_mix': gain(ks[12], (DEPTH, D_MODEL)),
        'w_in': nrm(ks[13], (DEPTH, D_MODEL, IN_COLS), D_MODEL ** -0.5),
        'conv_w': nrm(ks[14], (DEPTH, CONV_K, 2 * A_QK + A_V), CONV_K ** -0.5),
        'a_log': jnp.log(jax.random.uniform(ks[15], (DEPTH, 2, H_A), f32, 1.0, 16.0)),
        'dt_bias': dt + jnp.log(-jnp.expm1(-dt)),
        'delta_norm': gain(ks[17], (DEPTH, DV_A)),
        'lambda_q1': nrm(ks[18], (DEPTH, DQK_B), 0.1),
        'lambda_k1': nrm(ks[19], (DEPTH, DQK_B), 0.1),
        'lambda_q2': nrm(ks[20], (DEPTH, DQK_B), 0.1),
        'lambda_k2': nrm(ks[21], (DEPTH, DQK_B), 0.1),
        'diff_norm': gain(ks[22], (DEPTH, DV_B)),
        'w_out': nrm(ks[23], (DEPTH, MIX_WIDTH, D_MODEL), MIX_WIDTH ** -0.5),
        'norm_ffn2': gain(ks[24], (DEPTH, D_MODEL)),
        'w_ffn2_in': nrm(ks[25], (DEPTH, D_MODEL, 2 * D_FF), D_MODEL ** -0.5),
        'w_ffn2_out': nrm(ks[26], (DEPTH, D_FF, D_MODEL), D_FF ** -0.5),
        'norm_final': gain(ks[27], (D_MODEL,)),
    }


def reference(x_prompt, x_sample, cache_diff_k, cache_diff_v, state_delta, c, c_ctx,
              w_ada, b_ada, norm_ffn1, w_ffn1_in, w_ffn1_out, norm_mix, w_in, conv_w,
              a_log, dt_bias, delta_norm, lambda_q1, lambda_k1, lambda_q2, lambda_k2,
              diff_norm, w_out, norm_ffn2, w_ffn2_in, w_ffn2_out, norm_final):
    xp = x_prompt
    xs = x_sample
    new_k, new_v, new_s = [], [], []
    for l in range(DEPTH):
        lam_init = 0.8 - 0.6 * math.exp(-0.3 * l)
        lp = {
            'norm_ffn1': norm_ffn1[l], 'w_ffn1_in': w_ffn1_in[l], 'w_ffn1_out': w_ffn1_out[l],
            'norm_mix': norm_mix[l], 'w_in': w_in[l], 'conv_w': conv_w[l],
            'a_log': a_log[l], 'dt_bias': dt_bias[l], 'delta_norm': delta_norm[l],
            'lambda_q1': lambda_q1[l], 'lambda_k1': lambda_k1[l],
            'lambda_q2': lambda_q2[l], 'lambda_k2': lambda_k2[l],
            'diff_norm': diff_norm[l], 'w_out': w_out[l],
            'norm_ffn2': norm_ffn2[l], 'w_ffn2_in': w_ffn2_in[l], 'w_ffn2_out': w_ffn2_out[l],
        }
        xp, (k_ctx, v_ctx, s_ctx) = trunk_layer(xp, adaln(c_ctx, w_ada[l], b_ada[l]), lp, lam_init,
                                                None, None, None)
        new_k.append(k_ctx)
        new_v.append(v_ctx)
        new_s.append(s_ctx)
        xs, _ = trunk_layer(xs, adaln(c, w_ada[l], b_ada[l]), lp, lam_init,
                            cache_diff_k[:, l], cache_diff_v[:, l], state_delta[:, l])
    y_prompt = rmsnorm(xp, norm_final)
    y_sample = rmsnorm(xs, norm_final)
    new_diff_k = jnp.stack(new_k, axis=1)
    new_diff_v = jnp.stack(new_v, axis=1)
    new_state_delta = jnp.stack(new_s, axis=1)
    return (y_prompt, y_sample, new_diff_k, new_diff_v, new_state_delta)
```

```cpp
#include <hip/hip_runtime.h>
#include <hip/hip_cooperative_groups.h>
#include <cstdio>
namespace cg = cooperative_groups;

#ifndef MK_MULTI
#define MK_MULTI 1
#endif

#define DI __device__ __forceinline__
typedef unsigned short u16;
using bf16x8 = __attribute__((ext_vector_type(8))) short;
using s16x4  = __attribute__((ext_vector_type(4))) short;
using f32x4  = __attribute__((ext_vector_type(4))) float;
using f32x16 = __attribute__((ext_vector_type(16))) float;
using u32x2  = __attribute__((ext_vector_type(2))) unsigned;
using u32x4  = __attribute__((ext_vector_type(4))) unsigned;

extern __shared__ __attribute__((aligned(16))) char dsm[];

constexpr int T_TOK = 12288, T_P = 8192, DM = 1024, DFF = 2816;
constexpr int NKS = 16;
constexpr int LDS_BYTES = 145408;

constexpr size_t OFF_WB1 = 0;
constexpr size_t OFF_WB2 = OFF_WB1 + 11534336;
constexpr size_t OFF_WB3 = OFF_WB2 + 5767168;
constexpr size_t OFF_WB4 = OFF_WB3 + 7864320;
constexpr size_t OFF_WB5 = OFF_WB4 + 2097152;
constexpr size_t OFF_WB6 = OFF_WB5 + 11534336;
constexpr size_t OFF_MODP = OFF_WB6 + 5767168;
constexpr size_t OFF_MOD = OFF_MODP + (size_t)NKS * 5 * 9216 * 4;
constexpr size_t OFF_ROPE = OFF_MOD + 5 * 9216 * 4;
constexpr size_t OFF_CTR = OFF_ROPE + 8192;
constexpr size_t OFF_GB = OFF_CTR + 256;
constexpr size_t OFF_XN = OFF_GB + (size_t)T_TOK * 32 * 4;
constexpr size_t OFF_MIX = OFF_XN + (size_t)T_TOK * 1024 * 2;
constexpr size_t OFF_HID = OFF_MIX + (size_t)T_TOK * 1024 * 2;
constexpr size_t OFF_ZA = OFF_HID + (size_t)T_TOK * DFF * 2;
constexpr size_t OFF_Q = OFF_ZA + (size_t)T_TOK * 2048 * 2;
constexpr size_t OFF_KP = OFF_Q + (size_t)T_TOK * 512 * 2;
constexpr size_t OFF_KS = OFF_KP + (size_t)T_P * 512 * 2;
constexpr size_t OFF_VTP = OFF_KS + (size_t)4 * 1280 * 512 * 2;
constexpr size_t OFF_VTS = OFF_VTP + (size_t)T_P * 512 * 2;
constexpr size_t WS_END = OFF_VTS + (size_t)4 * 1280 * 512 * 2;

constexpr size_t OUT_Y = 0;
constexpr size_t OUT_K = 12582912;
constexpr size_t OUT_V = 16777216;
constexpr size_t OUT_S = 20971520;

struct P {
  const float *x_prompt, *x_sample, *cache_k, *cache_v, *state, *c, *c_ctx, *w_ada, *b_ada,
      *norm_ffn1, *w_ffn1_in, *w_ffn1_out, *norm_mix, *w_in, *conv_w, *a_log, *dt_bias, *delta_norm,
      *lq1, *lk1, *lq2, *lk2, *diff_norm, *w_out, *norm_ffn2, *w_ffn2_in, *w_ffn2_out, *norm_final;
  float* out;
  char* ws;
  int plo, phi;
};

DI u16 f2bf(float x) { return __builtin_bit_cast(u16, (__bf16)x); }
DI float bf2f(u16 b) { return __uint_as_float(((unsigned)b) << 16); }
DI unsigned pack2(float a, float b) { return (unsigned)f2bf(a) | ((unsigned)f2bf(b) << 16); }
DI float wave_sum(float v) {
#pragma unroll
  for (int o = 32; o; o >>= 1) v += __shfl_xor(v, o);
  return v;
}
typedef const P __attribute__((address_space(4)))* CP;
typedef const unsigned long long __attribute__((address_space(4)))* CU64;
DI int ltid(int wv) { int t = wv * 64 + (int)__builtin_amdgcn_mbcnt_hi(~0u, __builtin_amdgcn_mbcnt_lo(~0u, 0u)); asm volatile("" : "+v"(t)); return t; }
DI P ldp(CP pp) {
  asm volatile("" : "+s"(pp));
  P p; CU64 s = (CU64)pp; unsigned long long* d = (unsigned long long*)&p;
#pragma unroll
  for (int i = 0; i < 31; ++i) d[i] = s[i];
  return p;
}
DI float siluf(float x) { return x / (1.f + __expf(-x)); }
DI int tok_group(int t) { return t < T_P ? 0 : 1 + ((t - T_P) >> 10); }

DI void transpose_tile(const float* __restrict__ src, int nsrc, u16* __restrict__ dst, int K, int n0, int k0, int mode, int wv) {
  float* tl = (float*)dsm;
  const int tid = ltid(wv);
  for (int e = tid; e < 4096; e += 512) {
    int i = e >> 6, j = e & 63;
    int n = n0 + j, sc;
    if (mode == 1) { int pp = n >> 8, w = n & 255; sc = (w >> 7) * DFF + pp * 128 + (w & 127); }
    else if (mode == 2) { sc = n < 2048 ? n : (n < 3584 ? n + 32 : (n < 3616 ? n - 3584 + 2048 : -1)); }
    else sc = n;
    tl[i * 65 + j] = sc >= 0 ? src[(size_t)(k0 + i) * nsrc + sc] : 0.f;
  }
  __syncthreads();
  for (int e = tid; e < 2048; e += 512) {
    int jj = e >> 5, i2 = (e & 31) * 2;
    unsigned v = pack2(tl[i2 * 65 + jj], tl[(i2 + 1) * 65 + jj]);
    *(unsigned*)(dst + (size_t)(n0 + jj) * K + k0 + i2) = v;
  }
  __syncthreads();
}

DI void phase0(CP pp, int wv) {
  const P p = ldp(pp);
  const int tid = ltid(wv);
  u16* WB1 = (u16*)(p.ws + OFF_WB1); u16* WB2 = (u16*)(p.ws + OFF_WB2); u16* WB3 = (u16*)(p.ws + OFF_WB3);
  u16* WB4 = (u16*)(p.ws + OFF_WB4); u16* WB5 = (u16*)(p.ws + OFF_WB5); u16* WB6 = (u16*)(p.ws + OFF_WB6);
  float* MODP = (float*)(p.ws + OFF_MODP);
  constexpr int NA = 18 * NKS;
  constexpr int S1 = NA, S2 = S1 + 1408, S3 = S2 + 704, S4 = S3 + 960, S5 = S4 + 256, S6 = S5 + 1408, S7 = S6 + 704;
  constexpr int S8 = S7 + 1, S9 = S8 + 16, S10 = S9 + 16;
  for (int it = blockIdx.x; it < S10; it += gridDim.x) {
    if (it < NA) {
      float* sl = (float*)dsm;
      int cc = it % 18, ks = it / 18;
      __syncthreads();
      if (tid < 320) {
        int g = tid >> 6, k = tid & 63;
        float v = g == 0 ? p.c_ctx[ks * 64 + k] : p.c[(g - 1) * 1024 + ks * 64 + k];
        sl[tid] = v / (1.f + expf(-v));
      }
      __syncthreads();
      int col = cc * 512 + tid;
      float a0 = 0, a1 = 0, a2 = 0, a3 = 0, a4 = 0;
      const float* wp = p.w_ada + (size_t)(ks * 64) * 9216 + col;
#pragma unroll 8
      for (int k = 0; k < 64; ++k) {
        float w = wp[(size_t)k * 9216];
        a0 += sl[k] * w; a1 += sl[64 + k] * w; a2 += sl[128 + k] * w; a3 += sl[192 + k] * w; a4 += sl[256 + k] * w;
      }
      MODP[(size_t)(ks * 5 + 0) * 9216 + col] = a0; MODP[(size_t)(ks * 5 + 1) * 9216 + col] = a1;
      MODP[(size_t)(ks * 5 + 2) * 9216 + col] = a2; MODP[(size_t)(ks * 5 + 3) * 9216 + col] = a3;
      MODP[(size_t)(ks * 5 + 4) * 9216 + col] = a4;
      __syncthreads();
    } else if (it < S2) { int id = it - S1; transpose_tile(p.w_ffn1_in, 5632, WB1, 1024, (id % 88) * 64, (id / 88) * 64, 1, wv); }
    else if (it < S3) { int id = it - S2; transpose_tile(p.w_ffn1_out, 1024, WB2, DFF, (id % 16) * 64, (id / 16) * 64, 0, wv); }
    else if (it < S4) { int id = it - S3; transpose_tile(p.w_in, 3616, WB3, 1024, (id % 60) * 64, (id / 60) * 64, 2, wv); }
    else if (it < S5) { int id = it - S4; transpose_tile(p.w_out, 1024, WB4, 1024, (id % 16) * 64, (id / 16) * 64, 0, wv); }
    else if (it < S6) { int id = it - S5; transpose_tile(p.w_ffn2_in, 5632, WB5, 1024, (id % 88) * 64, (id / 88) * 64, 1, wv); }
    else if (it < S7) { int id = it - S6; transpose_tile(p.w_ffn2_out, 1024, WB6, DFF, (id % 16) * 64, (id / 16) * 64, 0, wv); }
    else if (it < S8) {
      float* rope = (float*)(p.ws + OFF_ROPE);
      for (int e = tid; e < 1024; e += 512) {
        int pos = e >> 4, i = e & 15;
        float inv = powf(10000.f, -(float)i / 16.f);
        float ang = (float)pos * inv;
        rope[e] = cosf(ang); rope[1024 + e] = sinf(ang);
      }
      if (tid == 0) *(int*)(p.ws + OFF_CTR) = 0;
    } else if (it < S9) {
      int id = it - S8;
      u16* KS = (u16*)(p.ws + OFF_KS);
      for (int e = tid; e < 64 * 256; e += 512) {
        int rr = id * 64 + (e >> 8), c2 = (e & 255) * 2;
        int b = rr >> 8, j = rr & 255;
        const float* s = p.cache_k + (size_t)rr * 512 + c2;
        *(unsigned*)(KS + ((size_t)b * 1280 + j) * 512 + c2) = pack2(s[0], s[1]);
      }
    } else {
      int id = it - S9; int b = id >> 2, head = id & 3;
      u16* VTS = (u16*)(p.ws + OFF_VTS);
      for (int e = tid; e < 32768; e += 512) {
        int key = e & 255, dv = e >> 8;
        float v = p.cache_v[(((size_t)b * 256 + key) * 4 + head) * 128 + dv];
        VTS[((size_t)(b * 4 + head) * 128 + dv) * 1280 + key] = f2bf(v);
      }
    }
  }
}

template <int which>
DI void norm_phase(CP pp, int wv) {
  const P p = ldp(pp);
  const int tid = ltid(wv), lane = tid & 63, wid = tid >> 6;
  const float* MODP = (const float*)(p.ws + OFF_MODP);
  float* MOD = (float*)(p.ws + OFF_MOD);
  u16* XN = (u16*)(p.ws + OFF_XN);
  if (which == 0) {
    for (int idx = blockIdx.x * 512 + tid; idx < 5 * 9216; idx += gridDim.x * 512) {
      int g = idx / 9216, j = idx - g * 9216;
      float a = p.b_ada[j];
      for (int ks = 0; ks < NKS; ++ks) a += MODP[(size_t)(ks * 5 + g) * 9216 + j];
      MOD[idx] = a;
    }
  }
  const float* gain = which == 0 ? p.norm_ffn1 : which == 1 ? p.norm_mix : which == 2 ? p.norm_ffn2 : p.norm_final;
  const int s_shift = which == 0 ? 0 : which == 1 ? 3 : 6;
  float gn[16], sh[16], sc[16];
#pragma unroll
  for (int i = 0; i < 4; ++i) {
    float4 g4 = *(const float4*)(gain + i * 256 + lane * 4);
    gn[i * 4] = g4.x; gn[i * 4 + 1] = g4.y; gn[i * 4 + 2] = g4.z; gn[i * 4 + 3] = g4.w;
  }
  const int nw = gridDim.x * 8, w = blockIdx.x * 8 + wid;
  const int rpw = (T_TOK + nw - 1) / nw;
  int gcur = -1;
  for (int t = w * rpw; t < min(T_TOK, (w + 1) * rpw); ++t) {
    const float* xr = which == 0 ? (t < T_P ? p.x_prompt + (size_t)t * 1024 : p.x_sample + (size_t)(t - T_P) * 1024)
                                 : p.out + OUT_Y + (size_t)t * 1024;
    float xv[16];
    float ss = 0.f;
#pragma unroll
    for (int i = 0; i < 4; ++i) {
      float4 v = *(const float4*)(xr + i * 256 + lane * 4);
      xv[i * 4] = v.x; xv[i * 4 + 1] = v.y; xv[i * 4 + 2] = v.z; xv[i * 4 + 3] = v.w;
      ss += v.x * v.x + v.y * v.y + v.z * v.z + v.w * v.w;
    }
    ss = wave_sum(ss);
    float rstd = rsqrtf(ss * (1.f / 1024.f) + 1e-6f);
    if (which == 3) {
      float* orow = p.out + OUT_Y + (size_t)t * 1024;
#pragma unroll
      for (int i = 0; i < 4; ++i) {
        float4 o;
        o.x = xv[i * 4] * rstd * gn[i * 4]; o.y = xv[i * 4 + 1] * rstd * gn[i * 4 + 1];
        o.z = xv[i * 4 + 2] * rstd * gn[i * 4 + 2]; o.w = xv[i * 4 + 3] * rstd * gn[i * 4 + 3];
        *(float4*)(orow + i * 256 + lane * 4) = o;
      }
      continue;
    }
    int g = tok_group(t);
    if (g != gcur) {
      gcur = g;
#pragma unroll
      for (int i = 0; i < 4; ++i) {
#pragma unroll
        for (int k = 0; k < 4; ++k) {
          int col = i * 256 + lane * 4 + k;
          float a, b;
          if (which == 0) {
            a = p.b_ada[col]; b = p.b_ada[1024 + col];
            for (int ks = 0; ks < NKS; ++ks) {
              a += MODP[(size_t)(ks * 5 + g) * 9216 + col];
              b += MODP[(size_t)(ks * 5 + g) * 9216 + 1024 + col];
            }
          } else {
            a = MOD[(g * 9 + s_shift) * 1024 + col];
            b = MOD[(g * 9 + s_shift + 1) * 1024 + col];
          }
          sh[i * 4 + k] = a; sc[i * 4 + k] = b;
        }
      }
    }
#pragma unroll
    for (int i = 0; i < 4; ++i) {
      float y0 = xv[i * 4] * rstd * gn[i * 4] * (1.f + sc[i * 4]) + sh[i * 4];
      float y1 = xv[i * 4 + 1] * rstd * gn[i * 4 + 1] * (1.f + sc[i * 4 + 1]) + sh[i * 4 + 1];
      float y2 = xv[i * 4 + 2] * rstd * gn[i * 4 + 2] * (1.f + sc[i * 4 + 2]) + sh[i * 4 + 2];
      float y3 = xv[i * 4 + 3] * rstd * gn[i * 4 + 3] * (1.f + sc[i * 4 + 3]) + sh[i * 4 + 3];
      u32x2 o; o.x = pack2(y0, y1); o.y = pack2(y2, y3);
      *(u32x2*)(XN + (size_t)t * 1024 + i * 256 + lane * 4) = o;
    }
  }
}

constexpr int BM = 256, BK = 64, HALF = 128, HT = HALF * BK;

DI int lds_byte(int r, int c) {
  int st = (r >> 4) * 2 + (c >> 5), rr = r & 15, cc = c & 31, ob = rr * 64 + cc * 2;
  return st * 1024 + (ob ^ (((ob >> 9) & 1) << 5));
}
DI void stage_rc(int b, int& R, int& C) {
  int st = b / 1024, sb = b % 1024, swz = sb ^ (((sb >> 9) & 1) << 5);
  R = (st >> 1) * 16 + swz / 64; C = (st & 1) * 32 + (swz % 64) / 2;
}

template <class Epi>
DI void gemm_phase(const u16* __restrict__ A, const u16* __restrict__ Bt, const int K, const int nM, const int nN, Epi epi, int wv) {
  u16* shm = (u16*)dsm;
#define SA(b, h) (shm + ((b) * 2 + (h)) * HT)
#define SB(b, h) (shm + (4 + (b) * 2 + (h)) * HT)
#define STAGE(Pp, BASE, br, kt) do { size_t _g = (size_t)(br) * K + (size_t)(kt) * BK; \
    for (int _i = 0; _i < 2; ++_i) { int _b = tidl * 16 + _i * 8192; int _r, _c; stage_rc(_b, _r, _c); \
      __builtin_amdgcn_global_load_lds((const unsigned*)(BASE + _g + (size_t)_r * K + _c), \
        (unsigned*)((char*)(Pp) + _b), 16, 0, 0); } } while (0)
#define LDA(dst, b, h) for (int m = 0; m < 4; ++m) for (int k = 0; k < 2; ++k) \
    dst[m][k] = *reinterpret_cast<const bf16x8*>((char*)SA(b, h) + lds_byte(wr * 64 + m * 16 + fr, k * 32 + fq * 8))
#define LDB(dst, b, h) for (int n = 0; n < 2; ++n) for (int k = 0; k < 2; ++k) \
    dst[n][k] = *reinterpret_cast<const bf16x8*>((char*)SB(b, h) + lds_byte(wc * 32 + n * 16 + fr, k * 32 + fq * 8))
#define MMA(ai, bj, At_, Bt_) do { __builtin_amdgcn_s_setprio(1); \
    for (int m = 0; m < 4; ++m) for (int n = 0; n < 2; ++n) for (int k = 0; k < 2; ++k) \
      acc[ai][bj][m][n] = __builtin_amdgcn_mfma_f32_16x16x32_bf16(Bt_[n][k], At_[m][k], acc[ai][bj][m][n], 0, 0, 0); \
    __builtin_amdgcn_s_setprio(0); } while (0)
#define WAIT_V(n) asm volatile("s_waitcnt vmcnt(" #n ")" ::: "memory")
#define WAIT_L(n) asm volatile("s_waitcnt lgkmcnt(" #n ")" ::: "memory")
#define BAR __builtin_amdgcn_s_barrier()
#define SCHED __builtin_amdgcn_sched_barrier(0)

  const int ntiles = nM * nN, per = ntiles / 8;
  const int nt = K / BK;
  for (int tix = blockIdx.x; tix < ntiles; tix += gridDim.x) {
    const int tidl = ltid(wv);
    const int wid = tidl >> 6, lane = tidl & 63, wr = wid >> 2, wc = wid & 3, fr = lane & 15, fq = lane >> 4;
    int lid = (tix & 7) * per + (tix >> 3);
    int nig = 8 * nN, grp = lid / nig, within = lid - grp * nig;
    int pm = grp * 8 + (within & 7), pn = within >> 3;
    int brow = pm * BM, bcol = pn * BM;
    f32x4 acc[2][2][4][2] = {};
    bf16x8 At[4][2], B0[2][2], B1[2][2];
    STAGE(SB(0, 0), Bt, bcol, 0); STAGE(SA(0, 0), A, brow, 0);
    STAGE(SB(0, 1), Bt, bcol + HALF, 0); STAGE(SA(0, 1), A, brow + HALF, 0);
    if (wr == 1) BAR;
    WAIT_V(4); BAR;
    STAGE(SB(1, 0), Bt, bcol, 1); STAGE(SA(1, 0), A, brow, 1); STAGE(SB(1, 1), Bt, bcol + HALF, 1);
    WAIT_V(6); BAR;
    for (int t = 0; t < nt - 2; t += 2) {
      LDB(B0, 0, 0); SCHED; LDA(At, 0, 0); STAGE(SA(1, 1), A, brow + HALF, t + 1);
      WAIT_L(8); BAR; WAIT_L(0); MMA(0, 0, At, B0); BAR; SCHED;
      LDB(B1, 0, 1); STAGE(SB(0, 0), Bt, bcol, t + 2);
      BAR; WAIT_L(0); MMA(0, 1, At, B1); BAR;
      LDA(At, 0, 1); STAGE(SA(0, 0), A, brow, t + 2);
      BAR; WAIT_L(0); MMA(1, 0, At, B0); BAR; SCHED;
      STAGE(SB(0, 1), Bt, bcol + HALF, t + 2);
      WAIT_V(6); BAR; MMA(1, 1, At, B1); BAR;
      LDB(B0, 1, 0); SCHED; LDA(At, 1, 0); STAGE(SA(0, 1), A, brow + HALF, t + 2);
      WAIT_L(8); BAR; WAIT_L(0); MMA(0, 0, At, B0); BAR; SCHED;
      LDB(B1, 1, 1); STAGE(SB(1, 0), Bt, bcol, t + 3);
      BAR; WAIT_L(0); MMA(0, 1, At, B1); BAR;
      LDA(At, 1, 1); STAGE(SA(1, 0), A, brow, t + 3);
      BAR; WAIT_L(0); MMA(1, 0, At, B0); BAR; SCHED;
      STAGE(SB(1, 1), Bt, bcol + HALF, t + 3);
      WAIT_V(6); BAR; MMA(1, 1, At, B1); BAR;
    }
    { LDB(B0, 0, 0); LDA(At, 0, 0); STAGE(SA(1, 1), A, brow + HALF, nt - 1);
      BAR; WAIT_L(0); MMA(0, 0, At, B0); BAR;
      LDB(B1, 0, 1); BAR; WAIT_L(0); MMA(0, 1, At, B1); BAR;
      LDA(At, 0, 1); WAIT_V(4); BAR; WAIT_L(0); MMA(1, 0, At, B0); MMA(1, 1, At, B1); BAR; }
    { LDB(B0, 1, 0); LDA(At, 1, 0); WAIT_V(2); BAR; WAIT_L(0); MMA(0, 0, At, B0); BAR;
      LDB(B1, 1, 1); WAIT_V(0); BAR; WAIT_L(0); MMA(0, 1, At, B1); BAR;
      LDA(At, 1, 1); BAR; WAIT_L(0); MMA(1, 0, At, B0); MMA(1, 1, At, B1); BAR; }
    if (wr == 0) BAR;
    {
      int t2 = ltid(wv);
      const int wid2 = t2 >> 6, lane2 = t2 & 63;
      epi(pm, pn, acc, wid2 >> 2, wid2 & 3, lane2 & 15, lane2 >> 4);
    }
    __syncthreads();
  }
#undef SA
#undef SB
#undef STAGE
#undef LDA
#undef LDB
#undef MMA
}

struct EpiSwiGLU {
  u16* HID;
  DI void operator()(int pm, int pn, f32x4 (&acc)[2][2][4][2], int wr, int wc, int fr, int fq) const {
#pragma unroll
    for (int ai = 0; ai < 2; ++ai)
#pragma unroll
      for (int m = 0; m < 4; ++m) {
        int t = pm * 256 + ai * 128 + wr * 64 + m * 16 + fr;
#pragma unroll
        for (int n = 0; n < 2; ++n) {
          int hc = pn * 128 + wc * 32 + n * 16 + fq * 4;
          f32x4 g = acc[ai][0][m][n], u = acc[ai][1][m][n];
          u32x2 o;
          o.x = pack2(siluf(g[0]) * u[0], siluf(g[1]) * u[1]);
          o.y = pack2(siluf(g[2]) * u[2], siluf(g[3]) * u[3]);
          *(u32x2*)(HID + (size_t)t * DFF + hc) = o;
        }
      }
  }
};

struct EpiResid {
  const float* xp; const float* xs;
  float* out; const float* MOD; int slot; float coef;
  DI void operator()(int pm, int pn, f32x4 (&acc)[2][2][4][2], int wr, int wc, int fr, int fq) const {
    const int g = pm < 32 ? 0 : 1 + ((pm - 32) >> 2);
    const float* gate = MOD + (g * 9 + slot) * 1024 + pn * 256;
    const float* xin = pm < 32 ? xp + (size_t)pm * 262144 + pn * 256 : xs + (size_t)(pm - 32) * 262144 + pn * 256;
    float* o = out + (size_t)pm * 262144 + pn * 256;
    const unsigned cbase = wc * 32 + fq * 4, rbase = wr * 64 + fr;
#pragma unroll
    for (int bj = 0; bj < 2; ++bj)
#pragma unroll
      for (int n = 0; n < 2; ++n) {
        const unsigned col = cbase + bj * 128 + n * 16;
        const float4 gt = *(const float4*)(gate + col);
#pragma unroll
        for (int ai = 0; ai < 2; ++ai)
#pragma unroll
          for (int m = 0; m < 4; ++m) {
            const unsigned off = (rbase + ai * 128 + m * 16) * 1024u + col;
            asm volatile("" ::: "memory");
            float4 xi = *(const float4*)(xin + off);
            f32x4 a = acc[ai][bj][m][n];
            float4 r;
            r.x = xi.x + coef * gt.x * a[0]; r.y = xi.y + coef * gt.y * a[1];
            r.z = xi.z + coef * gt.z * a[2]; r.w = xi.w + coef * gt.w * a[3];
            *(float4*)(o + off) = r;
          }
      }
  }
};

struct EpiInProj {
  char* ws; float* out;
  DI void operator()(int pm, int pn, f32x4 (&acc)[2][2][4][2], int wr, int wc, int fr, int fq) const {
    const bool sample = pm >= 32;
    const unsigned rbase = wr * 64 + fr;
    const unsigned cb0 = wc * 32 + fq * 4;
    if (pn < 8) {
      u16* ZA = (u16*)(ws + OFF_ZA) + (size_t)pm * 256 * 2048 + pn * 256;
#pragma unroll
      for (int ai = 0; ai < 2; ++ai)
#pragma unroll
        for (int m = 0; m < 4; ++m)
#pragma unroll
          for (int bj = 0; bj < 2; ++bj)
#pragma unroll
            for (int n = 0; n < 2; ++n) {
              f32x4 a = acc[ai][bj][m][n];
              u32x2 o; o.x = pack2(a[0], a[1]); o.y = pack2(a[2], a[3]);
              *(u32x2*)(ZA + (rbase + ai * 128 + m * 16) * 2048u + cb0 + bj * 128 + n * 16) = o;
            }
    } else if (pn < 12) {
      const bool isq = pn < 10;
      const float* rope = (const float*)(ws + OFF_ROPE);
      const unsigned cq = (pn & 1) * 256 + cb0;
      u16* dstb;
      unsigned rstride = 512;
      if (isq) dstb = (u16*)(ws + OFF_Q) + (size_t)pm * 256 * 512;
      else if (!sample) dstb = (u16*)(ws + OFF_KP) + (size_t)pm * 256 * 512;
      else dstb = (u16*)(ws + OFF_KS) + ((size_t)((pm - 32) >> 2) * 1280 + 256 + ((pm - 32) & 3) * 256) * 512;
      float* ko = out + OUT_K + (size_t)pm * 256 * 512;
      const int slb = ((pm - 32) & 3) * 256;
#pragma unroll
      for (int ai = 0; ai < 2; ++ai)
#pragma unroll
        for (int m = 0; m < 4; ++m) {
          const unsigned row = rbase + ai * 128 + m * 16;
          asm volatile("" ::: "memory");
          float4 cs = make_float4(1.f, 1.f, 1.f, 1.f), sn = make_float4(0.f, 0.f, 0.f, 0.f);
          if (sample) {
            int sl = slb + row;
            int pos = (wc & 1) ? (sl & 63) : (sl >> 6);
            cs = *(const float4*)(rope + pos * 16 + fq * 4);
            sn = *(const float4*)(rope + 1024 + pos * 16 + fq * 4);
          }
#pragma unroll
          for (int bj = 0; bj < 2; ++bj) {
            f32x4 v1 = acc[ai][bj][m][0], v2 = acc[ai][bj][m][1];
            const unsigned off = row * rstride + cq + bj * 128;
            if (!sample && !isq) {
              *(float4*)(ko + off) = make_float4(v1[0], v1[1], v1[2], v1[3]);
              *(float4*)(ko + off + 16) = make_float4(v2[0], v2[1], v2[2], v2[3]);
            }
            f32x4 o1, o2;
            o1[0] = v1[0] * cs.x - v2[0] * sn.x; o2[0] = v2[0] * cs.x + v1[0] * sn.x;
            o1[1] = v1[1] * cs.y - v2[1] * sn.y; o2[1] = v2[1] * cs.y + v1[1] * sn.y;
            o1[2] = v1[2] * cs.z - v2[2] * sn.z; o2[2] = v2[2] * cs.z + v1[2] * sn.z;
            o1[3] = v1[3] * cs.w - v2[3] * sn.w; o2[3] = v2[3] * cs.w + v1[3] * sn.w;
            if (isq) { o1 *= 0.125f; o2 *= 0.125f; }
            u32x2 o1p, o2p;
            o1p.x = pack2(o1[0], o1[1]); o1p.y = pack2(o1[2], o1[3]);
            o2p.x = pack2(o2[0], o2[1]); o2p.y = pack2(o2[2], o2[3]);
            *(u32x2*)(dstb + off) = o1p; *(u32x2*)(dstb + off + 16) = o2p;
          }
        }
    } else if (pn < 14) {
      const unsigned cv0 = (pn & 1) * 256 + cb0;
      if (!sample) {
        float* vo = out + OUT_V + (size_t)pm * 256 * 512;
        u16* vt = (u16*)(ws + OFF_VTP) + (size_t)pm * 4 * 128 * 256;
#pragma unroll
        for (int ai = 0; ai < 2; ++ai)
#pragma unroll
          for (int m = 0; m < 4; ++m)
#pragma unroll
            for (int bj = 0; bj < 2; ++bj)
#pragma unroll
              for (int n = 0; n < 2; ++n) {
                f32x4 a = acc[ai][bj][m][n];
                const unsigned row = rbase + ai * 128 + m * 16, cv = cv0 + bj * 128 + n * 16;
                *(float4*)(vo + row * 512u + cv) = make_float4(a[0], a[1], a[2], a[3]);
                u16* d = vt + cv * 256u + row;
                d[0] = f2bf(a[0]); d[256] = f2bf(a[1]); d[512] = f2bf(a[2]); d[768] = f2bf(a[3]);
              }
      } else {
        u16* vt = (u16*)(ws + OFF_VTS) + (size_t)((pm - 32) >> 2) * 4 * 128 * 1280 + 256 + ((pm - 32) & 3) * 256;
#pragma unroll
        for (int ai = 0; ai < 2; ++ai)
#pragma unroll
          for (int m = 0; m < 4; ++m)
#pragma unroll
            for (int bj = 0; bj < 2; ++bj)
#pragma unroll
              for (int n = 0; n < 2; ++n) {
                f32x4 a = acc[ai][bj][m][n];
                const unsigned row = rbase + ai * 128 + m * 16, cv = cv0 + bj * 128 + n * 16;
                u16* d = vt + cv * 1280u + row;
                d[0] = f2bf(a[0]); d[1280] = f2bf(a[1]); d[2560] = f2bf(a[2]); d[3840] = f2bf(a[3]);
              }
      }
    } else {
      if (wc == 0) {
        float* GB = (float*)(ws + OFF_GB) + (size_t)pm * 256 * 32;
#pragma unroll
        for (int ai = 0; ai < 2; ++ai)
#pragma unroll
          for (int m = 0; m < 4; ++m)
#pragma unroll
            for (int n = 0; n < 2; ++n) {
              f32x4 a = acc[ai][0][m][n];
              *(float4*)(GB + (rbase + ai * 128 + m * 16) * 32u + n * 16 + fq * 4) = make_float4(a[0], a[1], a[2], a[3]);
            }
      }
    }
  }
};

constexpr int LQS = 0, LKB = 9216, LVB = 18432, LA = 27648, LQK = 44032, LKG = 53248, LST = 62464, LSM = 71680, HSZ = 72704;

DI f32x4 mma16(bf16x8 a, bf16x8 b, f32x4 c) { return __builtin_amdgcn_mfma_f32_16x16x32_bf16(a, b, c, 0, 0, 0); }
DI f32x4 mma_nt64(const char* Aop, const char* Bop, int i0, int j0, int fr, int fq, f32x4 acc) {
#pragma unroll
  for (int ks = 0; ks < 2; ++ks) {
    bf16x8 a = *(const bf16x8*)(Aop + (i0 + fr) * 144 + (ks * 32 + fq * 8) * 2);
    bf16x8 b = *(const bf16x8*)(Bop + (j0 + fr) * 144 + (ks * 32 + fq * 8) * 2);
    acc = mma16(a, b, acc);
  }
  return acc;
}

DI void deltanet_item(const P& p, int item, int wv) {
  const int seq = item >> 3, h = item & 7;
  const bool sample = seq >= 32;
  const int L = sample ? 1024 : 256, N = L >> 6;
  const int base = sample ? T_P + (seq - 32) * 1024 : seq * 256;
  const u16* ZA = (const u16*)(p.ws + OFF_ZA);
  const float* GB = (const float*)(p.ws + OFF_GB);

  f32x4 sacc[4];
  {
  const int tid = ltid(wv), hf = tid >> 8, lt = tid & 255, lw = lt >> 6, lane = tid & 63, fr = lane & 15, fq = lane >> 4;
  char* hb = dsm + hf * HSZ;
#pragma unroll
  for (int dt = 0; dt < 4; ++dt) {
    if (sample) {
      const float* s0 = p.state + (((size_t)(seq - 32) * 2 + hf) * 8 + h) * 4096;
#pragma unroll
      for (int r = 0; r < 4; ++r) sacc[dt][r] = s0[(dt * 16 + fq * 4 + r) * 64 + lw * 16 + fr];
    } else {
      sacc[dt] = f32x4{0.f, 0.f, 0.f, 0.f};
    }
    u32x2 o; o.x = pack2(sacc[dt][0], sacc[dt][1]); o.y = pack2(sacc[dt][2], sacc[dt][3]);
    *(u32x2*)(hb + LST + (lw * 16 + fr) * 144 + (dt * 16 + fq * 4) * 2) = o;
  }
  }

  for (int n = 0; n < N; ++n) {
    const int tid = ltid(wv);
    const int hf = tid >> 8, lt = tid & 255, lw = lt >> 6, lane = tid & 63, fr = lane & 15, fq = lane >> 4;
    char* hb = dsm + hf * HSZ;
    float* sm = (float*)(hb + LSM);
    float* OB = (float*)(p.ws + OFF_HID) + (size_t)hf * T_TOK * 512;
    const int mch = hf ? N - 1 - n : n;
    if (lw == 0) {
      int c = lane;
      int tk = base + mch * 64 + (hf ? 63 - c : c);
      const float alog = -expf(p.a_log[hf * 8 + h]);
      const float dtb = p.dt_bias[hf * 8 + h];
      float ad = GB[(size_t)tk * 32 + hf * 8 + h] + dtb;
      float ab = GB[(size_t)tk * 32 + 16 + hf * 8 + h];
      float sp = ad > 20.f ? ad : log1pf(expf(ad));
      float g = alog * sp;
      float bt = 1.f / (1.f + expf(-ab));
      float gc = g;
#pragma unroll
      for (int o = 1; o < 64; o <<= 1) { float v = __shfl_up(gc, o); if (lane >= o) gc += v; }
      float gl = __shfl(gc, 63);
      sm[c] = gc; sm[64 + c] = bt; sm[128 + c] = expf(gc); sm[192 + c] = expf(gl - gc);
    }
    {
      const int d = lane, rg = lw;
      const int so = hf ? 48 - rg * 16 : rg * 16;
#pragma unroll
      for (int part = 0; part < 3; ++part) {
        const int ch = part * 512 + h * 64 + d;
        float cw[5];
#pragma unroll
        for (int j = 0; j < 5; ++j) cw[j] = p.conv_w[j * 1536 + ch];
        float zr[20];
#pragma unroll
        for (int i = 0; i < 20; ++i) {
          int s = mch * 64 + so - 2 + i;
          zr[i] = (s >= 0 && s < L) ? bf2f(ZA[(size_t)(base + s) * 2048 + ch]) : 0.f;
        }
#pragma unroll
        for (int i = 0; i < 16; ++i) {
          float v = cw[0] * zr[i] + cw[1] * zr[i + 1] + cw[2] * zr[i + 2] + cw[3] * zr[i + 3] + cw[4] * zr[i + 4];
          v = v / (1.f + __expf(-v));
          if (part < 2) {
            float ss = wave_sum(v * v);
            v *= rsqrtf(ss + 1e-6f);
            if (part == 0) v *= 0.125f;
          }
          int c = hf ? 63 - (so + i) : so + i;
          *(u16*)(hb + (part == 0 ? LQS : part == 1 ? LKB : LVB) + c * 144 + d * 2) = f2bf(v);
        }
      }
    }
    __syncthreads();
    {
#pragma unroll
      for (int jt = 0; jt < 4; ++jt) {
        f32x4 dk = mma_nt64(hb + LKB, hb + LKB, lw * 16, jt * 16, fr, fq, f32x4{0.f, 0.f, 0.f, 0.f});
        int s = jt * 16 + fr;
        float gs = sm[s];
#pragma unroll
        for (int r = 0; r < 4; ++r) {
          int c = lw * 16 + fq * 4 + r;
          float v = s < c ? sm[64 + c] * dk[r] * __expf(sm[c] - gs) : 0.f;
          *(float*)(hb + LA + (c * 64 + (s & 1) * 32 + (s >> 1)) * 4) = v;
        }
      }
#pragma unroll
      for (int it = 0; it < 4; ++it) {
        f32x4 dq = mma_nt64(hb + LKB, hb + LQS, it * 16, lw * 16, fr, fq, f32x4{0.f, 0.f, 0.f, 0.f});
        int c = lw * 16 + fr;
        float gcc = sm[c];
        float v[4];
#pragma unroll
        for (int r = 0; r < 4; ++r) {
          int s = it * 16 + fq * 4 + r;
          v[r] = s <= c ? dq[r] * __expf(gcc - sm[s]) : 0.f;
        }
        u32x2 o; o.x = pack2(v[0], v[1]); o.y = pack2(v[2], v[3]);
        *(u32x2*)(hb + LQK + c * 144 + (it * 16 + fq * 4) * 2) = o;
      }
    }
    __syncthreads();
    {
      const int d = lane, cg4 = lw;
#pragma unroll
      for (int i = 0; i < 16; i += 2) {
        int c = cg4 * 16 + i;
        float k0 = bf2f(*(const u16*)(hb + LKB + c * 144 + d * 2)) * sm[192 + c];
        float k1 = bf2f(*(const u16*)(hb + LKB + (c + 1) * 144 + d * 2)) * sm[192 + c + 1];
        *(unsigned*)(hb + LKG + d * 144 + c * 2) = pack2(k0, k1);
      }
    }
    float xp[32];
    const int sj = lt >> 1, par = lt & 1;
    {
      const float* Ab = (const float*)(hb + LA) + par * 32;
      const char* rsrc = (sj < 64) ? hb + LVB + sj * 2 : hb + LKB + (sj - 64) * 2;
#pragma unroll
      for (int i = 0; i < 32; ++i) xp[i] = 0.f;
#pragma unroll
      for (int c = 0; c < 64; ++c) {
        asm volatile("" ::: "memory");
        float rsc = (sj < 64) ? sm[64 + c] : sm[64 + c] * sm[128 + c];
        float rhs = rsc * bf2f(*(const u16*)(rsrc + c * 144));
        float a0 = 0.f, a1 = 0.f;
#pragma unroll
        for (int i = 0; i < (c + 1) / 2; ++i) {
          if (i & 1) a1 += Ab[c * 64 + i] * xp[i]; else a0 += Ab[c * 64 + i] * xp[i];
        }
        float part = a0 + a1;
        float oth = __int_as_float(__builtin_amdgcn_update_dpp(0, __float_as_int(part), 0xB1, 0xf, 0xf, false));
        float xc = rhs - (part + oth);
        xp[c >> 1] = (par == (c & 1)) ? xc : xp[c >> 1];
      }
    }
    __syncthreads();
    if (sj < 64) {
#pragma unroll
      for (int i = 0; i < 32; ++i) *(u16*)(hb + LVB + sj * 144 + (2 * i + par) * 2) = f2bf(xp[i]);
    } else {
#pragma unroll
      for (int i = 0; i < 32; ++i) *(u16*)(hb + LKB + (2 * i + par) * 144 + (sj - 64) * 2) = f2bf(xp[i]);
    }
    __syncthreads();
    {
#pragma unroll
      for (int ct = 0; ct < 4; ++ct) {
        f32x4 dd = mma_nt64(hb + LKB, hb + LST, ct * 16, lw * 16, fr, fq, f32x4{0.f, 0.f, 0.f, 0.f});
        int e = lw * 16 + fr;
        u32x2 u0 = *(const u32x2*)(hb + LVB + e * 144 + (ct * 16 + fq * 4) * 2);
        float v0 = __uint_as_float(u0.x << 16) - dd[0], v1 = __uint_as_float(u0.x & 0xffff0000u) - dd[1];
        float v2 = __uint_as_float(u0.y << 16) - dd[2], v3 = __uint_as_float(u0.y & 0xffff0000u) - dd[3];
        u32x2 o; o.x = pack2(v0, v1); o.y = pack2(v2, v3);
        *(u32x2*)(hb + LA + e * 144 + (ct * 16 + fq * 4) * 2) = o;
      }
    }
    __syncthreads();
    {
      const int c = lw * 16 + fr;
      const float egc = sm[128 + c];
      const int tk = base + mch * 64 + (hf ? 63 - c : c);
#pragma unroll
      for (int et = 0; et < 4; ++et) {
        f32x4 o = mma_nt64(hb + LST, hb + LQS, et * 16, lw * 16, fr, fq, f32x4{0.f, 0.f, 0.f, 0.f});
        o *= egc;
        o = mma_nt64(hb + LA, hb + LQK, et * 16, lw * 16, fr, fq, o);
        *(float4*)(OB + (size_t)tk * 512 + h * 64 + et * 16 + fq * 4) = make_float4(o[0], o[1], o[2], o[3]);
      }
      const float egl = sm[128 + 63];
#pragma unroll
      for (int dt = 0; dt < 4; ++dt) {
        sacc[dt] *= egl;
        sacc[dt] = mma_nt64(hb + LKG, hb + LA, dt * 16, lw * 16, fr, fq, sacc[dt]);
      }
    }
    __syncthreads();
#pragma unroll
    for (int dt = 0; dt < 4; ++dt) {
      u32x2 o; o.x = pack2(sacc[dt][0], sacc[dt][1]); o.y = pack2(sacc[dt][2], sacc[dt][3]);
      *(u32x2*)(hb + LST + (lw * 16 + fr) * 144 + (dt * 16 + fq * 4) * 2) = o;
    }
  }
  if (!sample) {
    const int tid = ltid(wv), hf = tid >> 8, lt = tid & 255, lw = lt >> 6, lane = tid & 63, fr = lane & 15, fq = lane >> 4;
    float* so = p.out + OUT_S + (((size_t)seq * 2 + hf) * 8 + h) * 4096;
#pragma unroll
    for (int dt = 0; dt < 4; ++dt)
#pragma unroll
      for (int r = 0; r < 4; ++r) so[(dt * 16 + fq * 4 + r) * 64 + lw * 16 + fr] = sacc[dt][r];
  }
  __syncthreads();
}

DI f32x16 mma32(bf16x8 a, bf16x8 b, f32x16 c) { return __builtin_amdgcn_mfma_f32_32x32x16_bf16(a, b, c, 0, 0, 0); }

DI void attn_item(const P& p, int item, int wv) {
  const int tid = ltid(wv), wid = tid >> 6, lane = tid & 63, r = lane & 31, h = lane >> 5;
  int b, head, qb, nk, tokbase;
  const u16* Kg; const u16* Vg;
  if (item < 64) {
    b = item >> 4; head = (item >> 2) & 3; qb = item & 3; nk = 1280; tokbase = T_P + b * 1024 + qb * 256;
    Kg = (const u16*)(p.ws + OFF_KS) + (size_t)b * 1280 * 512 + head * 128;
    Vg = (const u16*)(p.ws + OFF_VTS) + (size_t)(b * 4 + head) * 128 * 1280;
  } else {
    int id = item - 64; b = id >> 2; head = id & 3; qb = 0; nk = 256; tokbase = b * 256;
    Kg = (const u16*)(p.ws + OFF_KP) + (size_t)b * 256 * 512 + head * 128;
    Vg = (const u16*)(p.ws + OFF_VTP) + (size_t)(b * 4 + head) * 128 * 256;
  }
  float s1 = wave_sum(p.lq1[lane] * p.lk1[lane]);
  float s2 = wave_sum(p.lq2[lane] * p.lk2[lane]);
  const float lam = expf(s1) - expf(s2) + 0.2f;
  const int tq = tokbase + wid * 32 + r;
  const u16* Qg = (const u16*)(p.ws + OFF_Q) + (size_t)tq * 512 + head * 128;
  bf16x8 q[2][4];
#pragma unroll
  for (int mp = 0; mp < 2; ++mp)
#pragma unroll
    for (int ks = 0; ks < 4; ++ks) q[mp][ks] = *(const bf16x8*)(Qg + mp * 64 + ks * 16 + 8 * h);
  char* KT = dsm;
  char* VT = dsm + 17408;
  const int ntile = nk >> 6;
  float m0 = -1e30f, m1 = -1e30f, l0 = 0.f, l1 = 0.f;
  u32x4 kr[2];
  {
#pragma unroll
    for (int i = 0; i < 2; ++i) { int id = tid + 512 * i; int row = id >> 4, cp = id & 15;
      kr[i] = *(const u32x4*)(Kg + (size_t)row * 512 + cp * 8); }
  }
  for (int t = 0; t < ntile; ++t) {
    __syncthreads();
#pragma unroll
    for (int i = 0; i < 2; ++i) { int id = tid + 512 * i; int row = id >> 4, cp = id & 15;
      *(u32x4*)(KT + row * 272 + cp * 16) = kr[i]; }
    __syncthreads();
    if (t + 1 < ntile) {
#pragma unroll
      for (int i = 0; i < 2; ++i) { int id = tid + 512 * i; int row = id >> 4, cp = id & 15;
        kr[i] = *(const u32x4*)(Kg + (size_t)((t + 1) * 64 + row) * 512 + cp * 8); }
    }
#pragma unroll
    for (int kb2 = 0; kb2 < 2; ++kb2) {
      f32x16 sa = {}, sb = {};
#pragma unroll
      for (int ks = 0; ks < 4; ++ks) {
        bf16x8 a0 = *(const bf16x8*)(KT + (kb2 * 32 + r) * 272 + (ks * 16 + 8 * h) * 2);
        bf16x8 a1 = *(const bf16x8*)(KT + (kb2 * 32 + r) * 272 + (64 + ks * 16 + 8 * h) * 2);
        sa = mma32(a0, q[0][ks], sa); sb = mma32(a1, q[1][ks], sb);
      }
      float mx0 = sa[0], mx1 = sb[0];
#pragma unroll
      for (int i = 1; i < 16; ++i) { mx0 = fmaxf(mx0, sa[i]); mx1 = fmaxf(mx1, sb[i]); }
      float n0 = fmaxf(m0, mx0), n1 = fmaxf(m1, mx1);
      float a0 = 0.f, a1 = 0.f;
#pragma unroll
      for (int i = 0; i < 16; ++i) { a0 += __expf(sa[i] - n0); a1 += __expf(sb[i] - n1); }
      l0 = l0 * __expf(m0 - n0) + a0; l1 = l1 * __expf(m1 - n1) + a1;
      m0 = n0; m1 = n1;
    }
  }
  {
    float mo0 = __shfl_xor(m0, 32), lo0 = __shfl_xor(l0, 32), mo1 = __shfl_xor(m1, 32), lo1 = __shfl_xor(l1, 32);
    float M0 = fmaxf(m0, mo0), M1 = fmaxf(m1, mo1);
    l0 = l0 * __expf(m0 - M0) + lo0 * __expf(mo0 - M0);
    l1 = l1 * __expf(m1 - M1) + lo1 * __expf(mo1 - M1);
    m0 = M0; m1 = M1;
  }
  const float c0 = 1.f / l0, c1 = lam / l1;
  f32x16 oacc[4] = {};
  u32x4 vr[2];
  {
#pragma unroll
    for (int i = 0; i < 2; ++i) { int id = tid + 512 * i; int row = id >> 4, cp = id & 15;
      kr[i] = *(const u32x4*)(Kg + (size_t)row * 512 + cp * 8);
      int vrow = id >> 3, vcp = id & 7;
      vr[i] = *(const u32x4*)(Vg + (size_t)vrow * nk + vcp * 8); }
  }
  for (int t = 0; t < ntile; ++t) {
    __syncthreads();
#pragma unroll
    for (int i = 0; i < 2; ++i) { int id = tid + 512 * i; int row = id >> 4, cp = id & 15;
      *(u32x4*)(KT + row * 272 + cp * 16) = kr[i];
      int vrow = id >> 3, vcp = id & 7;
      *(u32x4*)(VT + vrow * 144 + vcp * 16) = vr[i]; }
    __syncthreads();
    if (t + 1 < ntile) {
#pragma unroll
      for (int i = 0; i < 2; ++i) { int id = tid + 512 * i; int row = id >> 4, cp = id & 15;
        kr[i] = *(const u32x4*)(Kg + (size_t)((t + 1) * 64 + row) * 512 + cp * 8);
        int vrow = id >> 3, vcp = id & 7;
        vr[i] = *(const u32x4*)(Vg + (size_t)vrow * nk + (t + 1) * 64 + vcp * 8); }
    }
#pragma unroll
    for (int kb2 = 0; kb2 < 2; ++kb2) {
      f32x16 sa = {}, sb = {};
#pragma unroll
      for (int ks = 0; ks < 4; ++ks) {
        bf16x8 a0 = *(const bf16x8*)(KT + (kb2 * 32 + r) * 272 + (ks * 16 + 8 * h) * 2);
        bf16x8 a1 = *(const bf16x8*)(KT + (kb2 * 32 + r) * 272 + (64 + ks * 16 + 8 * h) * 2);
        sa = mma32(a0, q[0][ks], sa); sb = mma32(a1, q[1][ks], sb);
      }
      float av[16];
#pragma unroll
      for (int i = 0; i < 16; ++i) av[i] = __expf(sa[i] - m0) * c0 - __expf(sb[i] - m1) * c1;
#pragma unroll
      for (int s = 0; s < 2; ++s) {
        u32x4 pp;
        pp.x = pack2(av[8 * s], av[8 * s + 1]); pp.y = pack2(av[8 * s + 2], av[8 * s + 3]);
        pp.z = pack2(av[8 * s + 4], av[8 * s + 5]); pp.w = pack2(av[8 * s + 6], av[8 * s + 7]);
        bf16x8 pb = __builtin_bit_cast(bf16x8, pp);
#pragma unroll
        for (int dvb = 0; dvb < 4; ++dvb) {
          const char* vp = VT + (dvb * 32 + r) * 144 + (kb2 * 32 + 16 * s + 4 * h) * 2;
          u32x2 lo = *(const u32x2*)(vp), hi = *(const u32x2*)(vp + 16);
          u32x4 vv; vv.x = lo.x; vv.y = lo.y; vv.z = hi.x; vv.w = hi.y;
          oacc[dvb] = mma32(__builtin_bit_cast(bf16x8, vv), pb, oacc[dvb]);
        }
      }
    }
  }
  float ss = 0.f;
#pragma unroll
  for (int dvb = 0; dvb < 4; ++dvb)
#pragma unroll
    for (int i = 0; i < 16; ++i) ss += oacc[dvb][i] * oacc[dvb][i];
  ss += __shfl_xor(ss, 32);
  const float rstd = rsqrtf(ss * (1.f / 128.f) + 1e-6f) * 0.8f;
  u16* MIX = (u16*)(p.ws + OFF_MIX) + (size_t)tq * 1024 + 512 + head * 128;
#pragma unroll
  for (int dvb = 0; dvb < 4; ++dvb)
#pragma unroll
    for (int g = 0; g < 4; ++g) {
      int dv = dvb * 32 + 8 * g + 4 * h;
      float4 dn = *(const float4*)(p.diff_norm + dv);
      u32x2 o;
      o.x = pack2(oacc[dvb][4 * g] * rstd * dn.x, oacc[dvb][4 * g + 1] * rstd * dn.y);
      o.y = pack2(oacc[dvb][4 * g + 2] * rstd * dn.z, oacc[dvb][4 * g + 3] * rstd * dn.w);
      *(u32x2*)(MIX + dv) = o;
    }
  __syncthreads();
}

DI void mixer_phase(CP pp, int wv) {
  const P p = ldp(pp);
  int* ctr = (int*)(p.ws + OFF_CTR);
  int* cur = (int*)(dsm + LDS_BYTES - 16);
  while (true) {
    __syncthreads();
    if (ltid(wv) == 0) *cur = atomicAdd(ctr, 1);
    __syncthreads();
    int it = *cur;
    __syncthreads();
    if (it >= 480) break;
    if (it < 32) deltanet_item(p, 256 + it, wv);
    else if (it < 288) deltanet_item(p, it - 32, wv);
    else attn_item(p, it - 288, wv);
  }
}

DI void combine_phase(CP pp, int wv) {
  const P p = ldp(pp);
  const int tidc = ltid(wv), lane = tidc & 63, wid = tidc >> 6;
  const float* OB = (const float*)(p.ws + OFF_HID);
  const u16* ZA = (const u16*)(p.ws + OFF_ZA);
  u16* MIX = (u16*)(p.ws + OFF_MIX);
  const float dn = p.delta_norm[lane];
  const int nw = gridDim.x * 8;
  for (int task = blockIdx.x * 8 + wid; task < T_TOK * 8; task += nw) {
    int t = task >> 3, h = task & 7;
    size_t idx = (size_t)t * 512 + h * 64 + lane;
    float o = OB[idx] + OB[(size_t)T_TOK * 512 + idx];
    float ss = wave_sum(o * o);
    float y = o * rsqrtf(ss * (1.f / 64.f) + 1e-6f) * dn;
    float z = bf2f(ZA[(size_t)t * 2048 + 1536 + h * 64 + lane]);
    MIX[(size_t)t * 1024 + h * 64 + lane] = f2bf(y * siluf(z));
  }
}

DI void gemm_dispatch(CP pp, int wv, int which) {
  const P p = ldp(pp);
  const u16* XN = (const u16*)(p.ws + OFF_XN);
  u16* HID = (u16*)(p.ws + OFF_HID);
  const float* MOD = (const float*)(p.ws + OFF_MOD);
  float* Y = p.out + OUT_Y;
  switch (which) {
    case 2: gemm_phase(XN, (const u16*)(p.ws + OFF_WB1), 1024, 48, 22, EpiSwiGLU{HID}, wv); break;
    case 3: gemm_phase(HID, (const u16*)(p.ws + OFF_WB2), DFF, 48, 4, EpiResid{p.x_prompt, p.x_sample, Y, MOD, 2, 0.5f}, wv); break;
    case 5: gemm_phase(XN, (const u16*)(p.ws + OFF_WB3), 1024, 48, 15, EpiInProj{p.ws, p.out}, wv); break;
    case 8: gemm_phase((const u16*)(p.ws + OFF_MIX), (const u16*)(p.ws + OFF_WB4), 1024, 48, 4, EpiResid{Y, Y + (size_t)T_P * 1024, Y, MOD, 5, 1.0f}, wv); break;
    case 10: gemm_phase(XN, (const u16*)(p.ws + OFF_WB5), 1024, 48, 22, EpiSwiGLU{HID}, wv); break;
    case 11: gemm_phase(HID, (const u16*)(p.ws + OFF_WB6), DFF, 48, 4, EpiResid{Y, Y + (size_t)T_P * 1024, Y, MOD, 8, 0.5f}, wv); break;
  }
}

__global__ void __launch_bounds__(512, 2) mega(P pv) {
  cg::grid_group grid = cg::this_grid();
  CP pp = (CP)__builtin_amdgcn_kernarg_segment_ptr();
  const int wv = __builtin_amdgcn_readfirstlane(threadIdx.x >> 6);
  const int plo = pp->plo, phi = pp->phi;
  for (int ph = plo; ph <= phi; ++ph) {
    if (ph > plo) grid.sync();
    switch (ph) {
      case 0: phase0(pp, wv); break;
      case 1: norm_phase<0>(pp, wv); break;
      case 4: norm_phase<1>(pp, wv); break;
      case 6: mixer_phase(pp, wv); break;
      case 7: combine_phase(pp, wv); break;
      case 9: norm_phase<2>(pp, wv); break;
      case 12: norm_phase<3>(pp, wv); break;
      default: gemm_dispatch(pp, wv, ph); break;
    }
  }
}

extern "C" void kernel_launch(void* const* d_in, const int* in_sizes, int n_in, void* d_out, int out_size,
                              void* d_ws, size_t ws_size, hipStream_t stream) {
  static int grid_blocks = 0;
  if (!grid_blocks) {
    int dev = 0, cus = 0, per_cu = 0;
    hipGetDevice(&dev);
    hipDeviceGetAttribute(&cus, hipDeviceAttributeMultiprocessorCount, dev);
    hipFuncSetAttribute((const void*)mega, hipFuncAttributeMaxDynamicSharedMemorySize, LDS_BYTES);
    hipOccupancyMaxActiveBlocksPerMultiprocessor(&per_cu, (const void*)mega, 512, LDS_BYTES);
    if (per_cu < 1) per_cu = 1;
    grid_blocks = cus * per_cu;
    if (grid_blocks > 256) grid_blocks = 256;
    grid_blocks &= ~7;
    if (ws_size < WS_END) fprintf(stderr, "workspace too small: %zu < %zu\n", ws_size, (size_t)WS_END);
  }
  P p{};
  const float** f = (const float**)&p;
  for (int i = 0; i < 28; ++i) f[i] = (const float*)d_in[i];
  p.out = (float*)d_out; p.ws = (char*)d_ws;
#if MK_MULTI
  for (int ph = 0; ph <= 12; ++ph) {
    p.plo = ph; p.phi = ph;
    hipLaunchKernelGGL(mega, dim3(grid_blocks), dim3(512), LDS_BYTES, stream, p);
  }
#else
  p.plo = 0; p.phi = 12;
  void* args[] = {&p};
  hipError_t e = hipLaunchCooperativeKernel((const void*)mega, dim3(grid_blocks), dim3(512), args, LDS_BYTES, stream);
  if (e != hipSuccess) fprintf(stderr, "cooperative launch failed: %s (grid %d)\n", hipGetErrorString(e), grid_blocks);
#endif
}
```

```cpp
#include <hip/hip_runtime.h>
#include <hip/hip_cooperative_groups.h>
#include <cstdio>
namespace cg = cooperative_groups;

#ifndef DN_REP
#define DN_REP 1
#endif
#ifndef AT_REP
#define AT_REP 1
#endif
#ifndef REPEAT_MASK
#define REPEAT_MASK 0
#endif
#ifndef MK_MULTI
#define MK_MULTI 0
#endif

#define DI __device__ __forceinline__
typedef unsigned short u16;
using bf16x8 = __attribute__((ext_vector_type(8))) short;
using s16x4  = __attribute__((ext_vector_type(4))) short;
using f32x4  = __attribute__((ext_vector_type(4))) float;
using f32x2  = __attribute__((ext_vector_type(2))) float;
using f32x16 = __attribute__((ext_vector_type(16))) float;
using u32x2  = __attribute__((ext_vector_type(2))) unsigned;
using u32x4  = __attribute__((ext_vector_type(4))) unsigned;

extern __shared__ __attribute__((aligned(16))) char dsm[];

constexpr int T_TOK = 12288, T_P = 8192, DM = 1024, DFF = 2816;
constexpr int NKS = 16;
constexpr int LDS_BYTES = 131072 + 64;

constexpr size_t OFF_WB1 = 0;
constexpr size_t OFF_WB2 = OFF_WB1 + 11534336;
constexpr size_t OFF_WB3 = OFF_WB2 + 5767168;
constexpr size_t OFF_WB4 = OFF_WB3 + 7864320;
constexpr size_t OFF_WB5 = OFF_WB4 + 2097152;
constexpr size_t OFF_WB6 = OFF_WB5 + 11534336;
constexpr size_t OFF_MODP = OFF_WB6 + 5767168;
constexpr size_t OFF_MOD = OFF_MODP + (size_t)NKS * 5 * 9216 * 4;
constexpr size_t OFF_ROPE = OFF_MOD + 5 * 9216 * 4;
constexpr size_t OFF_CTR = OFF_ROPE + 8192;
constexpr size_t OFF_GB = OFF_CTR + 256;
constexpr size_t OFF_XN = OFF_GB + (size_t)T_TOK * 32 * 4;
constexpr size_t OFF_MIX = OFF_XN + (size_t)T_TOK * 1024 * 2;
constexpr size_t OFF_HID = OFF_MIX + (size_t)T_TOK * 1024 * 2;
constexpr size_t OFF_ZA = OFF_HID + (size_t)T_TOK * DFF * 2;
constexpr size_t OFF_Q = OFF_ZA + (size_t)T_TOK * 2048 * 2;
constexpr size_t OFF_KP = OFF_Q + (size_t)T_TOK * 512 * 2;
constexpr size_t OFF_KS = OFF_KP + (size_t)T_P * 512 * 2;
constexpr size_t OFF_VTP = OFF_KS + (size_t)4 * 1280 * 512 * 2;
constexpr size_t OFF_VTS = OFF_VTP + (size_t)T_P * 512 * 2;
constexpr size_t OFF_BAR = OFF_VTS + (size_t)4 * 1280 * 512 * 2;
constexpr size_t WS_END = OFF_BAR + 16384;

constexpr size_t OUT_Y = 0;
constexpr size_t OUT_K = 12582912;
constexpr size_t OUT_V = 16777216;
constexpr size_t OUT_S = 20971520;

struct P {
  const float *x_prompt, *x_sample, *cache_k, *cache_v, *state, *c, *c_ctx, *w_ada, *b_ada,
      *norm_ffn1, *w_ffn1_in, *w_ffn1_out, *norm_mix, *w_in, *conv_w, *a_log, *dt_bias, *delta_norm,
      *lq1, *lk1, *lq2, *lk2, *diff_norm, *w_out, *norm_ffn2, *w_ffn2_in, *w_ffn2_out, *norm_final;
  float* out;
  char* ws;
  int plo, phi;
};

DI u16 f2bf(float x) { return __builtin_bit_cast(u16, (__bf16)x); }
DI float bf2f(u16 b) { return __uint_as_float(((unsigned)b) << 16); }
DI unsigned pack2(float a, float b) { return (unsigned)f2bf(a) | ((unsigned)f2bf(b) << 16); }
#define DPPF(v, ctrl, rmask) __int_as_float(__builtin_amdgcn_update_dpp(0, __float_as_int(v), ctrl, rmask, 0xf, false))
DI float wave_sum(float v) {
  v += DPPF(v, 0xB1, 0xf); v += DPPF(v, 0x4E, 0xf); v += DPPF(v, 0x141, 0xf); v += DPPF(v, 0x140, 0xf);
  v += DPPF(v, 0x142, 0xa); v += DPPF(v, 0x143, 0xc);
  return __int_as_float(__builtin_amdgcn_readlane(__float_as_int(v), 63));
}
DI float quad_bcast(float v, int k) {
  switch (k & 3) {
    case 0: return DPPF(v, 0x00, 0xf);
    case 1: return DPPF(v, 0x55, 0xf);
    case 2: return DPPF(v, 0xAA, 0xf);
    default: return DPPF(v, 0xFF, 0xf);
  }
}
DI float oct_sum(float v) {
  v += DPPF(v, 0xB1, 0xf); v += DPPF(v, 0x4E, 0xf); v += DPPF(v, 0x141, 0xf);
  return v;
}
typedef const P __attribute__((address_space(4)))* CP;
typedef const unsigned long long __attribute__((address_space(4)))* CU64;
DI int ltid(int wv) { unsigned m = ~0u; asm volatile("" : "+s"(m)); int t = wv * 64 + (int)__builtin_amdgcn_mbcnt_hi(m, __builtin_amdgcn_mbcnt_lo(m, 0u)); asm volatile("" : "+v"(t)); return t; }
DI P ldp(CP pp) {
  asm volatile("" : "+s"(pp));
  P p; CU64 s = (CU64)pp; unsigned long long* d = (unsigned long long*)&p;
#pragma unroll
  for (int i = 0; i < 31; ++i) d[i] = s[i];
  return p;
}

#define XB_TMO      128
#define XB_XCNT(j)  (256  + 64 * (j))
#define XB_XSUB(j)  (1280 + 64 * (j))
#define XB_XGEN(j)  (2304 + 64 * (j))
#define XB_TOP      3328
#define XB_TOPGEN   3392
#define XCD_BAR_WORDS 3456
#define XB_SPIN_CAP (1u << 20)
DI unsigned xb_ld(unsigned* p) { return __hip_atomic_load(p, __ATOMIC_RELAXED, __HIP_MEMORY_SCOPE_AGENT); }
DI unsigned xb_add(unsigned* p, unsigned v) { return __hip_atomic_fetch_add(p, v, __ATOMIC_RELAXED, __HIP_MEMORY_SCOPE_AGENT); }
DI unsigned xb_xcc_id() { return (unsigned)__builtin_amdgcn_s_getreg((3 << 11) | 20) & 0xFu; }
#define XB_SPIN(cond, bar) do { unsigned _sp = 0; while (cond) { __builtin_amdgcn_s_sleep(1); \
    if ((++_sp & 255u) == 0u) { if (xb_ld(&(bar)[XB_TMO])) break; if (_sp > XB_SPIN_CAP) { atomicAdd(&(bar)[XB_TMO], 1u); break; } } } } while (0)
DI void xcd_barrier_complete(unsigned* bar, unsigned x, unsigned& nloc, unsigned& nx) {
  const unsigned G = gridDim.x;
  unsigned sum, cnt, mine, sp = 0u;
  for (;;) {
    sum = 0u; cnt = 0u; mine = 0u;
#pragma unroll
    for (unsigned j = 0; j < 16; ++j) { const unsigned c = xb_ld(&bar[XB_XCNT(j)]); sum += c; cnt += (c > 0u) ? 1u : 0u; mine = (j == x) ? c : mine; }
    if (sum == G) break;
    __builtin_amdgcn_s_sleep(1);
    if ((++sp & 255u) == 0u) { if (xb_ld(&bar[XB_TMO])) break; if (sp > XB_SPIN_CAP) { atomicAdd(&bar[XB_TMO], 1u); break; } }
  }
  nloc = mine > 0u ? mine : 1u; nx = cnt > 0u ? cnt : 1u;
}
DI void gbar_post(CP pp, int wv) {
  volatile unsigned* st = (volatile unsigned*)(dsm + LDS_BYTES - 32);
  if (ltid(wv) == 0) {
    unsigned* bar = (unsigned*)(pp->ws + OFF_BAR);
    st[0] = 0u; st[1] = 0u;
    (void)xb_add(&bar[XB_XCNT(xb_xcc_id())], 1u);
  }
  __syncthreads();
}
DI void gbar(CP pp, int wv) {
  asm volatile("s_waitcnt vmcnt(0)" ::: "memory");
  __syncthreads();
  if (ltid(wv) == 0) {
    unsigned* bar = (unsigned*)(pp->ws + OFF_BAR);
    volatile unsigned* st = (volatile unsigned*)(dsm + LDS_BYTES - 32);
    const unsigned x = xb_xcc_id();
    __builtin_amdgcn_s_waitcnt(0);
    unsigned nloc = st[0], nx = st[1];
    if (nloc == 0u) { xcd_barrier_complete(bar, x, nloc, nx); st[0] = nloc; st[1] = nx; }
    const unsigned old = xb_add(&bar[XB_XSUB(x)], 1u);
    const unsigned gen = old / nloc;
    if (old + 1u == (gen + 1u) * nloc) {
      __builtin_amdgcn_fence(__ATOMIC_RELEASE, "agent");
      asm volatile("s_waitcnt vmcnt(0)" ::: "memory");
      const unsigned og = xb_add(&bar[XB_TOP], 1u);
      const unsigned tg = og / nx;
      if (og + 1u == (tg + 1u) * nx) xb_add(&bar[XB_TOPGEN], 1u);
      else XB_SPIN(xb_ld(&bar[XB_TOPGEN]) == tg, bar);
      __builtin_amdgcn_fence(__ATOMIC_ACQUIRE, "agent");
      xb_add(&bar[XB_XGEN(x)], 1u);
      asm volatile("s_waitcnt vmcnt(0)" ::: "memory");
    } else {
      XB_SPIN(xb_ld(&bar[XB_XGEN(x)]) == gen, bar);
      __builtin_amdgcn_fence(__ATOMIC_ACQUIRE, "agent");
      asm volatile("s_waitcnt vmcnt(0)" ::: "memory");
    }
  }
  __syncthreads();
}
DI float4 nt_load4(const float* p) { f32x4 v = __builtin_nontemporal_load((const f32x4*)p); return make_float4(v[0], v[1], v[2], v[3]); }
DI void nt_store4(float4 v, float* p) { f32x4 t = {v.x, v.y, v.z, v.w}; __builtin_nontemporal_store(t, (f32x4*)p); }
DI float siluf(float x) { return x * __builtin_amdgcn_rcpf(1.f + __builtin_amdgcn_exp2f(-1.4426950408889634f * x)); }
DI int tok_group(int t) { return t < T_P ? 0 : 1 + ((t - T_P) >> 10); }

DI void transpose_tile(const float* __restrict__ src, int nsrc, u16* __restrict__ dst, int K, int n0, int k0, int mode, int wv) {
  float* tl = (float*)dsm;
  const int tid = ltid(wv);
  float4 v[8];
#pragma unroll
  for (int i = 0; i < 8; ++i) {
    int e = tid + 512 * i;
    int k = e >> 6, n = n0 + (e & 63) * 4, sc;
    if (mode == 1 || (mode == 2 && (n < 2048 || (n >= 3072 && n < 3584)))) { const int rho = n & 31, nf = rho >> 4, i = rho & 15; n = (n & ~31) + 8 * (i >> 2) + 4 * nf + (i & 3); }
    if (mode == 1) { int pp = n >> 8, w = n & 255; sc = (w >> 7) * DFF + pp * 128 + (w & 127); }
    else if (mode == 2) { sc = n < 2048 ? n : (n < 3584 ? n + 32 : (n < 3616 ? n - 3584 + 2048 : -1)); }
    else sc = n;
    v[i] = sc >= 0 ? nt_load4(src + (size_t)(k0 + k) * nsrc + sc) : make_float4(0.f, 0.f, 0.f, 0.f);
  }
#pragma unroll
  for (int i = 0; i < 8; ++i) {
    int e = tid + 512 * i;
    int k = e >> 6, j = (e & 63) * 4;
    tl[k * 257 + j] = v[i].x; tl[k * 257 + j + 1] = v[i].y; tl[k * 257 + j + 2] = v[i].z; tl[k * 257 + j + 3] = v[i].w;
  }
  __syncthreads();
#pragma unroll
  for (int i = 0; i < 8; ++i) {
    int e = tid + 512 * i;
    int n = e >> 4, kq = (e & 15) * 4;
    u32x2 o;
    o.x = pack2(tl[kq * 257 + n], tl[(kq + 1) * 257 + n]);
    o.y = pack2(tl[(kq + 2) * 257 + n], tl[(kq + 3) * 257 + n]);
    *(u32x2*)(dst + (size_t)(n0 + n) * K + k0 + kq) = o;
  }
  __syncthreads();
}

DI void phase0(CP pp, int wv, int misc_first = -1, int misc_stride = 1) {
  const P p = ldp(pp);
  const bool misc = misc_first >= 0;
  const int tid = ltid(wv);
  u16* WB1 = (u16*)(p.ws + OFF_WB1); u16* WB2 = (u16*)(p.ws + OFF_WB2); u16* WB3 = (u16*)(p.ws + OFF_WB3);
  u16* WB4 = (u16*)(p.ws + OFF_WB4); u16* WB5 = (u16*)(p.ws + OFF_WB5); u16* WB6 = (u16*)(p.ws + OFF_WB6);
  float* MODP = (float*)(p.ws + OFF_MODP);
  constexpr int NA = 256;
  constexpr int S1 = NA, S2 = S1 + 352, S3 = S2 + 176, S4 = S3 + 240, S5 = S4 + 64, S6 = S5 + 352, S7 = S6 + 176;
  constexpr int S8 = S7 + 1, S9 = S8 + 16, S10 = S9 + 16;
  for (int it = misc ? S7 + misc_first : (int)blockIdx.x; it < (misc ? S10 : S2); it += misc ? misc_stride : (int)gridDim.x) {
    if (it >= S2 && it < S7) continue;
    if (it < NA) {
      float* sl = (float*)dsm;
      float* red = sl + 5120;
      __syncthreads();
      for (int e = tid; e < 5120; e += 512) {
        int g = e >> 10, k = e & 1023;
        float v = g == 0 ? p.c_ctx[k] : p.c[(g - 1) * 1024 + k];
        sl[e] = v / (1.f + expf(-v));
      }
      __syncthreads();
      const int c0 = it * 36;
      if (tid < 504) {
        const int kg = tid / 36, col = tid - kg * 36;
        float a0 = 0, a1 = 0, a2 = 0, a3 = 0, a4 = 0;
        const float* wp = p.w_ada + c0 + col;
#pragma unroll 1
        for (int i0 = 0; i0 < 74; i0 += 19) {
          float wv_[19];
#pragma unroll
          for (int j = 0; j < 19; ++j) { const int k = kg + 14 * (i0 + j); wv_[j] = (i0 + j < 74 && k < 1024) ? __builtin_nontemporal_load(wp + (size_t)k * 9216) : 0.f; }
#pragma unroll
          for (int j = 0; j < 19; ++j) {
            const int k = min(kg + 14 * (i0 + j), 1023); const float w = wv_[j];
            a0 += sl[k] * w; a1 += sl[1024 + k] * w; a2 += sl[2048 + k] * w; a3 += sl[3072 + k] * w; a4 += sl[4096 + k] * w;
          }
        }
        float* r = red + (kg * 36 + col) * 5;
        r[0] = a0; r[1] = a1; r[2] = a2; r[3] = a3; r[4] = a4;
      }
      __syncthreads();
      if (tid < 180) {
        const int col = tid / 5, g = tid - col * 5;
        float a = p.b_ada[c0 + col];
#pragma unroll
        for (int kg = 0; kg < 14; ++kg) a += red[(kg * 36 + col) * 5 + g];
        ((float*)(p.ws + OFF_MOD))[g * 9216 + c0 + col] = a;
      }
      __syncthreads();
    } else if (it < S2) { int id = it - S1; transpose_tile(p.w_ffn1_in, 5632, WB1, 1024, (id % 22) * 256, (id / 22) * 64, 1, wv); }
    else if (it < S3) { int id = it - S2; transpose_tile(p.w_ffn1_out, 1024, WB2, DFF, (id % 4) * 256, (id / 4) * 64, 0, wv); }
    else if (it < S4) { int id = it - S3; transpose_tile(p.w_in, 3616, WB3, 1024, (id % 15) * 256, (id / 15) * 64, 2, wv); }
    else if (it < S5) { int id = it - S4; transpose_tile(p.w_out, 1024, WB4, 1024, (id % 4) * 256, (id / 4) * 64, 0, wv); }
    else if (it < S6) { int id = it - S5; transpose_tile(p.w_ffn2_in, 5632, WB5, 1024, (id % 22) * 256, (id / 22) * 64, 1, wv); }
    else if (it < S7) { int id = it - S6; transpose_tile(p.w_ffn2_out, 1024, WB6, DFF, (id % 4) * 256, (id / 4) * 64, 0, wv); }
    else if (it < S8) {
      float* rope = (float*)(p.ws + OFF_ROPE);
      for (int e = tid; e < 1024; e += 512) {
        int pos = e >> 4, i = e & 15;
        float inv = powf(10000.f, -(float)i / 16.f);
        float ang = (float)pos * inv;
        rope[e] = cosf(ang); rope[1024 + e] = sinf(ang);
      }
      if (tid < 4) ((int*)(p.ws + OFF_CTR))[tid] = 0;
    } else if (it < S9) {
      int id = it - S8;
      u16* KS = (u16*)(p.ws + OFF_KS);
      for (int e = tid; e < 64 * 256; e += 512) {
        int rr = id * 64 + (e >> 8), c2 = (e & 255) * 2;
        int b = rr >> 8, j = rr & 255;
        const float* s = p.cache_k + (size_t)rr * 512 + c2;
        const int rho = c2 & 31, cp2 = (c2 & ~31) + 8 * ((rho & 15) >> 2) + 4 * (rho >> 4) + (rho & 3);
        *(unsigned*)(KS + ((size_t)b * 1280 + j) * 512 + cp2) = pack2(s[0], s[1]);
      }
    } else {
      int id = it - S9;
      u16* VS = (u16*)(p.ws + OFF_VTS);
      for (int e = tid; e < 64 * 256; e += 512) {
        int rr = id * 64 + (e >> 8), c2 = (e & 255) * 2;
        int b = rr >> 8, j = rr & 255;
        const float* s = p.cache_v + (size_t)rr * 512 + c2;
        *(unsigned*)(VS + ((size_t)b * 1280 + j) * 512 + c2) = pack2(s[0], s[1]);
      }
    }
  }
}

template <int which>
DI void norm_phase(CP pp, int wv) {
  const P p = ldp(pp);
  const int tid = ltid(wv), lane = tid & 63, wid = tid >> 6;
  const float* MODP = (const float*)(p.ws + OFF_MODP);
  float* MOD = (float*)(p.ws + OFF_MOD);
  u16* XN = (u16*)(p.ws + OFF_XN);
  const float* gain = which == 0 ? p.norm_ffn1 : which == 1 ? p.norm_mix : which == 2 ? p.norm_ffn2 : p.norm_final;
  constexpr int s_shift = which == 0 ? 0 : which == 1 ? 3 : 6;
  float4 gn[4], sh[4], sc[4];
#pragma unroll
  for (int i = 0; i < 4; ++i) gn[i] = *(const float4*)(gain + i * 256 + lane * 4);
  int gcur = -1;
  for (int w = blockIdx.x * 8 + wid; w < 2048; w += gridDim.x * 8)
  for (int half = 0; half < 1; ++half) {
    const int t0 = w * 6;
    float4 xv[6][4];
#pragma unroll
    for (int rr = 0; rr < 6; ++rr) {
      const int t = t0 + rr;
      const float* xr = which == 0 ? (t < T_P ? p.x_prompt + (size_t)t * 1024 : p.x_sample + (size_t)(t - T_P) * 1024)
                                   : p.out + OUT_Y + (size_t)t * 1024;
#pragma unroll
      for (int i = 0; i < 4; ++i) xv[rr][i] = *(const float4*)(xr + i * 256 + lane * 4);
    }
#pragma unroll
    for (int rr = 0; rr < 6; ++rr) {
      const int t = t0 + rr;
      float ss = 0.f;
#pragma unroll
      for (int i = 0; i < 4; ++i) ss += xv[rr][i].x * xv[rr][i].x + xv[rr][i].y * xv[rr][i].y + xv[rr][i].z * xv[rr][i].z + xv[rr][i].w * xv[rr][i].w;
      ss = wave_sum(ss);
      const float rstd = rsqrtf(ss * (1.f / 1024.f) + 1e-6f);
      if (which == 3) {
        float* orow = p.out + OUT_Y + (size_t)t * 1024;
#pragma unroll
        for (int i = 0; i < 4; ++i) {
          float4 o;
          o.x = xv[rr][i].x * rstd * gn[i].x; o.y = xv[rr][i].y * rstd * gn[i].y;
          o.z = xv[rr][i].z * rstd * gn[i].z; o.w = xv[rr][i].w * rstd * gn[i].w;
          nt_store4(o, orow + i * 256 + lane * 4);
        }
      } else {
        const int g = tok_group(t);
        if (g != gcur) {
          gcur = g;
#pragma unroll
          for (int i = 0; i < 4; ++i) {
            const int col = i * 256 + lane * 4;
            {
              sh[i] = *(const float4*)(MOD + (g * 9 + s_shift) * 1024 + col);
              sc[i] = *(const float4*)(MOD + (g * 9 + s_shift + 1) * 1024 + col);
            }
          }
        }
#pragma unroll
        for (int i = 0; i < 4; ++i) {
          float y0 = xv[rr][i].x * rstd * gn[i].x * (1.f + sc[i].x) + sh[i].x;
          float y1 = xv[rr][i].y * rstd * gn[i].y * (1.f + sc[i].y) + sh[i].y;
          float y2 = xv[rr][i].z * rstd * gn[i].z * (1.f + sc[i].z) + sh[i].z;
          float y3 = xv[rr][i].w * rstd * gn[i].w * (1.f + sc[i].w) + sh[i].w;
          u32x2 o; o.x = pack2(y0, y1); o.y = pack2(y2, y3);
          *(u32x2*)(XN + (size_t)t * 1024 + i * 256 + lane * 4) = o;
        }
      }
    }
  }
}

constexpr int BM = 256, BK = 64, HALF = 128, HT = HALF * BK;

DI int lds_byte(int r, int c) {
  int st = (r >> 4) * 2 + (c >> 5), rr = r & 15, cc = c & 31, ob = rr * 64 + cc * 2;
  return st * 1024 + (ob ^ (((ob >> 9) & 1) << 5));
}
DI void stage_rc(int b, int& R, int& C) {
  int st = b / 1024, sb = b % 1024, swz = sb ^ (((sb >> 9) & 1) << 5);
  R = (st >> 1) * 16 + swz / 64; C = (st & 1) * 32 + (swz % 64) / 2;
}

template <int MT, class Epi>
DI void gemm_phase(const u16* __restrict__ A, const u16* __restrict__ Bt, const int K, const int nM, const int nN, Epi epi, int wv) {
  u16* shm = (u16*)dsm;
#define SA(b, h) (shm + ((b) * 2 + (h)) * HT)
#define SB(b, h) (shm + (4 + (b) * 2 + (h)) * HT)
#define STAGE(Pp, BASE, br, kt) do { const char* _gb = (const char*)(BASE) + ((size_t)(br) * K + (size_t)(kt) * BK) * 2; \
    __builtin_amdgcn_global_load_lds((const unsigned*)(_gb + voff0), (unsigned*)((char*)(Pp) + tidl * 16), 16, 0, 0); \
    __builtin_amdgcn_global_load_lds((const unsigned*)(_gb + voff1), (unsigned*)((char*)(Pp) + tidl * 16 + 8192), 16, 0, 0); } while (0)
#define LDA(dst, b, h) for (int m = 0; m < MT; ++m) for (int k = 0; k < 2; ++k) \
    dst[m][k] = *reinterpret_cast<const bf16x8*>((char*)SA(b, h) + lds_byte(wr * (MT * 16) + m * 16 + fr, k * 32 + fq * 8))
#define LDB(dst, b, h) for (int n = 0; n < 2; ++n) for (int k = 0; k < 2; ++k) \
    dst[n][k] = *reinterpret_cast<const bf16x8*>((char*)SB(b, h) + lds_byte(wc * 32 + n * 16 + fr, k * 32 + fq * 8))
#define MMA(ai, bj, At_, Bt_) do { __builtin_amdgcn_s_setprio(1); \
    for (int m = 0; m < MT; ++m) for (int n = 0; n < 2; ++n) for (int k = 0; k < 2; ++k) \
      acc[ai][bj][m][n] = __builtin_amdgcn_mfma_f32_16x16x32_bf16(Bt_[n][k], At_[m][k], acc[ai][bj][m][n], 0, 0, 0); \
    __builtin_amdgcn_s_setprio(0); } while (0)
#define WAIT_V(n) asm volatile("s_waitcnt vmcnt(" #n ")" ::: "memory")
#define WAIT_L(n) asm volatile("s_waitcnt lgkmcnt(" #n ")" ::: "memory")
#define WAIT_LA do { if (MT == 4) asm volatile("s_waitcnt lgkmcnt(8)" ::: "memory"); else asm volatile("s_waitcnt lgkmcnt(6)" ::: "memory"); } while (0)
#define BAR __builtin_amdgcn_s_barrier()
#define SCHED __builtin_amdgcn_sched_barrier(0)

  const int ntiles = nM * nN, per = ntiles / 8;
  const int nt = K / BK;
  int tix = blockIdx.x;
  if (tix < ntiles) {
    const int tidl = ltid(wv);
    const int wid = tidl >> 6, lane = tidl & 63, wr = wid >> 2, wc = wid & 3, fr = lane & 15, fq = lane >> 4;
    unsigned voff0, voff1;
    { int _r, _c; stage_rc(tidl * 16, _r, _c); voff0 = (unsigned)(_r * K + _c) * 2u;
      stage_rc(tidl * 16 + 8192, _r, _c); voff1 = (unsigned)(_r * K + _c) * 2u; }
    const int wgm = nM >> 3, nig = wgm * nN;
    int pm, pn;
    { int lid = (tix & 7) * per + (tix >> 3); int grp = lid / nig, within = lid - grp * nig; pm = grp * wgm + within % wgm; pn = within / wgm; }
    int brow = pm * (MT * 64), bcol = pn * BM;
    bf16x8 At[MT][2], B0[2][2], B1[2][2];
    STAGE(SB(0, 0), Bt, bcol, 0); STAGE(SA(0, 0), A, brow, 0);
    STAGE(SB(0, 1), Bt, bcol + HALF, 0); STAGE(SA(0, 1), A, brow + MT * 32, 0);
    if (wr == 1) BAR;
    WAIT_V(4); BAR;
    STAGE(SB(1, 0), Bt, bcol, 1); STAGE(SA(1, 0), A, brow, 1); STAGE(SB(1, 1), Bt, bcol + HALF, 1);
    WAIT_V(6); BAR;
    while (true) {
      const int ntix = tix + gridDim.x;
      const bool has_next = ntix < ntiles;
      int npm, npn;
      { int lid = ((has_next ? ntix : tix) & 7) * per + ((has_next ? ntix : tix) >> 3); int grp = lid / nig, within = lid - grp * nig; npm = grp * wgm + within % wgm; npn = within / wgm; }
      const int nbrow = npm * (MT * 64), nbcol = npn * BM;
      f32x4 acc[2][2][MT][2] = {};
      for (int t = 0; t < nt; t += 2) {
        const bool last = t + 2 >= nt;
        const int rA = last ? nbrow : brow, rB = last ? nbcol : bcol, k2 = last ? 0 : t + 2, k3 = last ? 1 : t + 3;
        LDB(B0, 0, 0); SCHED; LDA(At, 0, 0); STAGE(SA(1, 1), A, brow + MT * 32, t + 1);
        WAIT_LA; BAR; WAIT_L(0); MMA(0, 0, At, B0); BAR; SCHED;
        LDB(B1, 0, 1); STAGE(SB(0, 0), Bt, rB, k2);
        BAR; WAIT_L(0); MMA(0, 1, At, B1); BAR;
        LDA(At, 0, 1); STAGE(SA(0, 0), A, rA, k2);
        BAR; WAIT_L(0); MMA(1, 0, At, B0); BAR; SCHED;
        STAGE(SB(0, 1), Bt, rB + HALF, k2);
        WAIT_V(6); BAR; MMA(1, 1, At, B1); BAR;
        LDB(B0, 1, 0); SCHED; LDA(At, 1, 0); STAGE(SA(0, 1), A, rA + MT * 32, k2);
        WAIT_LA; BAR; WAIT_L(0); MMA(0, 0, At, B0); BAR; SCHED;
        LDB(B1, 1, 1); STAGE(SB(1, 0), Bt, rB, k3);
        BAR; WAIT_L(0); MMA(0, 1, At, B1); BAR;
        LDA(At, 1, 1); STAGE(SA(1, 0), A, rA, k3);
        BAR; WAIT_L(0); MMA(1, 0, At, B0); BAR; SCHED;
        STAGE(SB(1, 1), Bt, rB + HALF, k3);
        WAIT_V(6); BAR; MMA(1, 1, At, B1); BAR;
      }
      {
        int t2 = ltid(wv);
        const int wid2 = t2 >> 6, lane2 = t2 & 63;
        epi(pm, pn, acc, wid2 >> 2, wid2 & 3, lane2 & 15, lane2 >> 4);
      }
      WAIT_V(0);
      if (!has_next) break;
      tix = ntix; pm = npm; pn = npn; brow = nbrow; bcol = nbcol;
    }
    if (wr == 0) BAR;
    __syncthreads();
  }
#undef WAIT_LA
#undef SA
#undef SB
#undef STAGE
#undef LDA
#undef LDB
#undef MMA
}

struct EpiSwiGLU {
  u16* HID;
  DI void operator()(int pm, int pn, f32x4 (&acc)[2][2][4][2], int wr, int wc, int fr, int fq) const {
#pragma unroll
    for (int ai = 0; ai < 2; ++ai)
#pragma unroll
      for (int m = 0; m < 4; ++m) {
        int t = pm * 256 + ai * 128 + wr * 64 + m * 16 + fr;
        {
          const int hc = pn * 128 + wc * 32 + fq * 8;
          f32x4 g0 = acc[ai][0][m][0], u0 = acc[ai][1][m][0], g1 = acc[ai][0][m][1], u1 = acc[ai][1][m][1];
          u32x4 o;
          o.x = pack2(siluf(g0[0]) * u0[0], siluf(g0[1]) * u0[1]);
          o.y = pack2(siluf(g0[2]) * u0[2], siluf(g0[3]) * u0[3]);
          o.z = pack2(siluf(g1[0]) * u1[0], siluf(g1[1]) * u1[1]);
          o.w = pack2(siluf(g1[2]) * u1[2], siluf(g1[3]) * u1[3]);
          *(u32x4*)(HID + (size_t)t * DFF + hc) = o;
        }
      }
  }
};

struct EpiResid {
  const float* xp; const float* xs;
  float* out; const float* MOD; int slot; float coef;
  DI void operator()(int pm, int pn, f32x4 (&acc)[2][2][4][2], int wr, int wc, int fr, int fq) const {
    const int g = pm < 32 ? 0 : 1 + ((pm - 32) >> 2);
    const float* gate = MOD + (g * 9 + slot) * 1024 + pn * 256;
    const float* xin = pm < 32 ? xp + (size_t)pm * 262144 + pn * 256 : xs + (size_t)(pm - 32) * 262144 + pn * 256;
    float* o = out + (size_t)pm * 262144 + pn * 256;
    const unsigned cbase = wc * 32 + fq * 4, rbase = wr * 64 + fr;
#pragma unroll
    for (int bj = 0; bj < 2; ++bj)
#pragma unroll
      for (int n = 0; n < 2; ++n) {
        const unsigned col = cbase + bj * 128 + n * 16;
        const float4 gt = *(const float4*)(gate + col);
#pragma unroll
        for (int aim = 0; aim < 4; ++aim) {
          const int ai = aim >> 1;
          asm volatile("" ::: "memory");
          float4 xi[2][4];
#pragma unroll
          for (int m = (aim & 1) * 2; m < (aim & 1) * 2 + 2; ++m) xi[ai][m] = *(const float4*)(xin + (rbase + ai * 128 + m * 16) * 1024u + col);
#pragma unroll
          for (int m = (aim & 1) * 2; m < (aim & 1) * 2 + 2; ++m) {
            const unsigned off = (rbase + ai * 128 + m * 16) * 1024u + col;
            f32x4 a = acc[ai][bj][m][n];
            float4 r;
            r.x = xi[ai][m].x + coef * gt.x * a[0]; r.y = xi[ai][m].y + coef * gt.y * a[1];
            r.z = xi[ai][m].z + coef * gt.z * a[2]; r.w = xi[ai][m].w + coef * gt.w * a[3];
            *(float4*)(o + off) = r;
          }
        }
      }
  }
};

struct EpiResid192 {
  const float* xp; const float* xs; float* out; const float* MOD; int slot; float coef;
  DI void operator()(int pm, int pn, f32x4 (&acc)[2][2][3][2], int wr, int wc, int fr, int fq) const {
    const unsigned cbase = pn * 256 + wc * 32 + fq * 4;
#pragma unroll
    for (int bj = 0; bj < 2; ++bj) {
      asm volatile("" ::: "memory");
      float4 xi[2][3][2];
#pragma unroll
      for (int ai = 0; ai < 2; ++ai)
#pragma unroll
        for (int m = 0; m < 3; ++m) {
          const int t = pm * 192 + ai * 96 + wr * 48 + m * 16 + fr;
          const float* xin = t < T_P ? xp + (size_t)t * 1024 : xs + (size_t)(t - T_P) * 1024;
#pragma unroll
          for (int n = 0; n < 2; ++n) xi[ai][m][n] = *(const float4*)(xin + cbase + bj * 128 + n * 16);
        }
#pragma unroll
      for (int ai = 0; ai < 2; ++ai)
#pragma unroll
        for (int m = 0; m < 3; ++m) {
          const int t = pm * 192 + ai * 96 + wr * 48 + m * 16 + fr;
          const float* gate = MOD + (tok_group(t) * 9 + slot) * 1024;
          float* o = out + (size_t)t * 1024;
#pragma unroll
          for (int n = 0; n < 2; ++n) {
            const float4 gt = *(const float4*)(gate + cbase + bj * 128 + n * 16);
            f32x4 a = acc[ai][bj][m][n];
            float4 r;
            r.x = xi[ai][m][n].x + coef * gt.x * a[0]; r.y = xi[ai][m][n].y + coef * gt.y * a[1];
            r.z = xi[ai][m][n].z + coef * gt.z * a[2]; r.w = xi[ai][m][n].w + coef * gt.w * a[3];
            *(float4*)(o + cbase + bj * 128 + n * 16) = r;
          }
        }
    }
  }
};

struct EpiInProj {
  char* ws; float* out;
  DI void operator()(int pm, int pn, f32x4 (&acc)[2][2][4][2], int wr, int wc, int fr, int fq) const {
    const bool sample = pm >= 32;
    const unsigned rbase = wr * 64 + fr;
    const unsigned cb0 = wc * 32 + fq * 4;
    if (pn < 8) {
      u16* ZA = (u16*)(ws + OFF_ZA) + (size_t)pm * 256 * 2048 + pn * 256;
#pragma unroll
      for (int ai = 0; ai < 2; ++ai)
#pragma unroll
        for (int m = 0; m < 4; ++m)
#pragma unroll
          for (int bj = 0; bj < 2; ++bj) {
            f32x4 a = acc[ai][bj][m][0], b = acc[ai][bj][m][1];
            u32x4 o; o.x = pack2(a[0], a[1]); o.y = pack2(a[2], a[3]); o.z = pack2(b[0], b[1]); o.w = pack2(b[2], b[3]);
            *(u32x4*)(ZA + (rbase + ai * 128 + m * 16) * 2048u + wc * 32 + fq * 8 + bj * 128) = o;
          }
    } else if (pn < 12) {
      const bool isq = pn < 10;
      const float* rope = (const float*)(ws + OFF_ROPE);
      const unsigned cq = (pn & 1) * 256 + cb0;
      u16* dstb;
      unsigned rstride = 512;
      if (isq) dstb = (u16*)(ws + OFF_Q) + (size_t)pm * 256 * 512;
      else if (!sample) dstb = (u16*)(ws + OFF_KP) + (size_t)pm * 256 * 512;
      else dstb = (u16*)(ws + OFF_KS) + ((size_t)((pm - 32) >> 2) * 1280 + 256 + ((pm - 32) & 3) * 256) * 512;
      float* ko = out + OUT_K + (size_t)pm * 256 * 512;
      const int slb = ((pm - 32) & 3) * 256;
#pragma unroll
      for (int ai = 0; ai < 2; ++ai) {
        asm volatile("" ::: "memory");
        float4 csv[4], snv[4];
#pragma unroll
        for (int m = 0; m < 4; ++m) {
          csv[m] = make_float4(1.f, 1.f, 1.f, 1.f); snv[m] = make_float4(0.f, 0.f, 0.f, 0.f);
          if (sample) {
            int sl = slb + rbase + ai * 128 + m * 16;
            int pos = (wc & 1) ? (sl & 63) : (sl >> 6);
            csv[m] = *(const float4*)(rope + pos * 16 + fq * 4);
            snv[m] = *(const float4*)(rope + 1024 + pos * 16 + fq * 4);
          }
        }
#pragma unroll
        for (int m = 0; m < 4; ++m) {
          const unsigned row = rbase + ai * 128 + m * 16;
          const float4 cs = csv[m], sn = snv[m];
#pragma unroll
          for (int bj = 0; bj < 2; ++bj) {
            f32x4 v1 = acc[ai][bj][m][0], v2 = acc[ai][bj][m][1];
            const unsigned off = row * rstride + cq + bj * 128;
            if (!sample && !isq) {
              nt_store4(make_float4(v1[0], v1[1], v1[2], v1[3]), ko + off);
              nt_store4(make_float4(v2[0], v2[1], v2[2], v2[3]), ko + off + 16);
            }
            f32x4 o1, o2;
            o1[0] = v1[0] * cs.x - v2[0] * sn.x; o2[0] = v2[0] * cs.x + v1[0] * sn.x;
            o1[1] = v1[1] * cs.y - v2[1] * sn.y; o2[1] = v2[1] * cs.y + v1[1] * sn.y;
            o1[2] = v1[2] * cs.z - v2[2] * sn.z; o2[2] = v2[2] * cs.z + v1[2] * sn.z;
            o1[3] = v1[3] * cs.w - v2[3] * sn.w; o2[3] = v2[3] * cs.w + v1[3] * sn.w;
            if (isq) { o1 *= 0.18033688011112042f; o2 *= 0.18033688011112042f; }
            u32x2 o1p, o2p;
            o1p.x = pack2(o1[0], o1[1]); o1p.y = pack2(o1[2], o1[3]);
            o2p.x = pack2(o2[0], o2[1]); o2p.y = pack2(o2[2], o2[3]);
            {
              u32x4 oq; oq.x = o1p.x; oq.y = o1p.y; oq.z = o2p.x; oq.w = o2p.y;
              *(u32x4*)(dstb + row * rstride + (pn & 1) * 256 + bj * 128 + wc * 32 + fq * 8) = oq;
            }
          }
        }
      }
    } else if (pn < 14) {
      const unsigned cv0 = (pn & 1) * 256 + wc * 32 + fq * 8;
      float* vo = out + OUT_V + (size_t)pm * 256 * 512;
      u16* vb = sample ? (u16*)(ws + OFF_VTS) + ((size_t)((pm - 32) >> 2) * 1280 + 256 + ((pm - 32) & 3) * 256) * 512
                       : (u16*)(ws + OFF_VTP) + (size_t)pm * 256 * 512;
#pragma unroll
      for (int ai = 0; ai < 2; ++ai)
#pragma unroll
        for (int m = 0; m < 4; ++m)
#pragma unroll
          for (int bj = 0; bj < 2; ++bj) {
            f32x4 a = acc[ai][bj][m][0], b = acc[ai][bj][m][1];
            const unsigned off = (rbase + ai * 128 + m * 16) * 512u + cv0 + bj * 128;
            if (!sample) {
              nt_store4(make_float4(a[0], a[1], a[2], a[3]), vo + off);
              nt_store4(make_float4(b[0], b[1], b[2], b[3]), vo + off + 4);
            }
            u32x4 o; o.x = pack2(a[0], a[1]); o.y = pack2(a[2], a[3]); o.z = pack2(b[0], b[1]); o.w = pack2(b[2], b[3]);
            *(u32x4*)(vb + off) = o;
          }
    } else {
      if (wc == 0) {
        float* GB = (float*)(ws + OFF_GB) + (size_t)pm * 256 * 32;
#pragma unroll
        for (int ai = 0; ai < 2; ++ai)
#pragma unroll
          for (int m = 0; m < 4; ++m)
#pragma unroll
            for (int n = 0; n < 2; ++n) {
              f32x4 a = acc[ai][0][m][n];
              *(float4*)(GB + (rbase + ai * 128 + m * 16) * 32u + n * 16 + fq * 4) = make_float4(a[0], a[1], a[2], a[3]);
            }
      }
    }
  }
};

constexpr int LQS = 0, LKB = 9216, LVB = 18432, LA = 27648, LQK = 44032, LKG = 53248, LST = 62464, LSM = 71680, HSZ = 73216, LW2 = 81920, LU2 = 91136;

DI f32x4 mma16(bf16x8 a, bf16x8 b, f32x4 c) { return __builtin_amdgcn_mfma_f32_16x16x32_bf16(a, b, c, 0, 0, 0); }
DI f32x4 mma_nt64(const char* Aop, const char* Bop, int i0, int j0, int fr, int fq, f32x4 acc) {
#pragma unroll
  for (int ks = 0; ks < 2; ++ks) {
    bf16x8 a = *(const bf16x8*)(Aop + (i0 + fr) * 144 + (ks * 32 + fq * 8) * 2);
    bf16x8 b = *(const bf16x8*)(Bop + (j0 + fr) * 144 + (ks * 32 + fq * 8) * 2);
    acc = mma16(a, b, acc);
  }
  return acc;
}

constexpr int LCW = HSZ;
DI void conv_decode(int item, int& m, int& h, int& L, int& base) {
  if (item < 1024) { const int seq = item >> 5; m = (item >> 3) & 3; h = item & 7; L = 256; base = seq * 256; }
  else { const int i2 = item - 1024; m = (i2 >> 3) & 15; h = i2 & 7; L = 1024; base = T_P + (i2 >> 7) * 1024; }
}
DI void conv_load(const P& p, const u16* ZA, int item, int tid, u32x4 (&zr)[4], float (&cwv)[2]) {
  int m, h, L, base; conv_decode(item, m, h, L, base);
#pragma unroll
  for (int i = 0; i < 4; ++i) {
    int id = tid + 512 * i;
    int row = id / 24, rem = id - row * 24;
    int s = m * 64 - 2 + row;
    u32x4 v = {0u, 0u, 0u, 0u};
    if (id < 1632 && s >= 0 && s < L) v = *(const u32x4*)(ZA + (size_t)(base + s) * 2048 + (rem >> 3) * 512 + h * 64 + (rem & 7) * 8);
    zr[i] = v;
  }
#pragma unroll
  for (int i = 0; i < 2; ++i) {
    int e = tid + 512 * i; cwv[i] = 0.f;
    if (e < 960) { int part = e / 320, r2 = e - part * 320, j = r2 >> 6, d = r2 & 63; cwv[i] = p.conv_w[j * 1536 + part * 512 + h * 64 + d]; }
  }
}
DI void conv_phase(CP pp, int wv) {
  const P p = ldp(pp);
  const u16* ZA = (const u16*)(p.ws + OFF_ZA);
  u16* QK = (u16*)(p.ws + OFF_XN);
  u16* VV = (u16*)(p.ws + OFF_WB1);
  u32x4 zr[4]; float cwv[2];
  if ((int)blockIdx.x < 1536) conv_load(p, ZA, blockIdx.x, ltid(wv), zr, cwv);
  for (int item = blockIdx.x; item < 1536; item += gridDim.x) {
    int m, h, L, base; conv_decode(item, m, h, L, base);
    const int tid = ltid(wv), lw = tid >> 6, lane = tid & 63;
    __syncthreads();
#pragma unroll
    for (int i = 0; i < 4; ++i) { int id = tid + 512 * i; if (id < 1632) *(u32x4*)(dsm + id * 16) = zr[i]; }
#pragma unroll
    for (int i = 0; i < 2; ++i) { int e = tid + 512 * i; if (e < 960) ((float*)(dsm + 26624))[e] = cwv[i]; }
    __syncthreads();
    if (item + (int)gridDim.x < 1536) conv_load(p, ZA, item + gridDim.x, tid, zr, cwv);
    {
      const int d = lane, so = lw * 8;
      const float* cwl = (const float*)(dsm + 26624);
#pragma unroll
      for (int part = 0; part < 3; ++part) {
        float cw[5];
#pragma unroll
        for (int j = 0; j < 5; ++j) cw[j] = cwl[part * 320 + j * 64 + d];
        float zv[12];
#pragma unroll
        for (int i = 0; i < 12; ++i) zv[i] = bf2f(*(const u16*)(dsm + (so + i) * 384 + part * 128 + d * 2));
#pragma unroll
        for (int i = 0; i < 8; ++i) {
          float v = cw[0] * zv[i] + cw[1] * zv[i + 1] + cw[2] * zv[i + 2] + cw[3] * zv[i + 3] + cw[4] * zv[i + 4];
          v = siluf(v);
          if (part < 2) {
            float ss = wave_sum(v * v);
            v *= rsqrtf(ss + 1e-6f);
            if (part == 0) v *= 0.125f;
          }
          const size_t t = (size_t)(base + m * 64 + so + i);
          if (part < 2) QK[((t * 8 + h) * 2 + part) * 64 + d] = f2bf(v);
          else VV[(t * 8 + h) * 64 + d] = f2bf(v);
        }
      }
    }
  }
  __syncthreads();
}
DI void dn_prefetch(const u16* QK, const u16* VV, const float* GB, int base, int mch, int hf, int h, int tid, u32x4 (&zr)[3], float& gad, float& gab) {
  const int r = (tid & 511) >> 3, cp = tid & 7;
  const size_t t = (size_t)(base + mch * 64 + r);
  zr[0] = *(const u32x4*)(QK + ((t * 8 + h) * 2 + 0) * 64 + cp * 8);
  zr[1] = *(const u32x4*)(QK + ((t * 8 + h) * 2 + 1) * 64 + cp * 8);
  zr[2] = *(const u32x4*)(VV + (t * 8 + h) * 64 + cp * 8);
  if (tid < 64) {
    int tk = base + mch * 64 + (hf ? 63 - tid : tid);
    gad = GB[(size_t)tk * 32 + hf * 8 + h];
    gab = GB[(size_t)tk * 32 + 16 + hf * 8 + h];
  }
}

DI void deltanet_item(const P& p, int item, int wv) {
  const int seq = item >> 4, h = (item >> 1) & 7, hf = item & 1;
  const bool sample = seq >= 32;
  const int L = sample ? 1024 : 256, N = L >> 6;
  const int base = sample ? T_P + (seq - 32) * 1024 : seq * 256;
  const u16* QK = (const u16*)(p.ws + OFF_XN);
  const u16* VV = (const u16*)(p.ws + OFF_WB1);
  const float* GB = (const float*)(p.ws + OFF_GB);
  char* hb = dsm;
  float* sm = (float*)(hb + LSM);
  u16* OB = (u16*)(p.ws + OFF_HID) + (size_t)hf * T_TOK * 512;
  const float alog = -expf(p.a_log[hf * 8 + h]);
  const float dtb = p.dt_bias[hf * 8 + h];

  f32x4 sacc[2];
  u32x4 zr[3]; float gad = 0.f, gab = 0.f;
  {
    const int tid = ltid(wv), lw = tid >> 6, lane = tid & 63, fr = lane & 15, fq = lane >> 4;
#pragma unroll
    for (int k = 0; k < 2; ++k) {
      const int dt = 2 * (lw >> 2) + k, et = lw & 3;
      if (sample) {
        const float* s0 = p.state + (((size_t)(seq - 32) * 2 + hf) * 8 + h) * 4096;
#pragma unroll
        for (int r = 0; r < 4; ++r) sacc[k][r] = s0[(dt * 16 + fq * 4 + r) * 64 + et * 16 + fr];
      } else {
        sacc[k] = f32x4{0.f, 0.f, 0.f, 0.f};
      }
      u32x2 o; o.x = pack2(sacc[k][0], sacc[k][1]); o.y = pack2(sacc[k][2], sacc[k][3]);
      *(u32x2*)(hb + LST + (et * 16 + fr) * 144 + (dt * 16 + fq * 4) * 2) = o;
    }
    dn_prefetch(QK, VV, GB, base, hf ? N - 1 : 0, hf, h, tid, zr, gad, gab);
  }

  for (int n = 0; n < N; ++n) {
    const int tid = ltid(wv);
    const int lw = tid >> 6, lane = tid & 63, fr = lane & 15, fq = lane >> 4;
    const int wq = lw & 3, wh = lw >> 2;
    const int mch = hf ? N - 1 - n : n;
    {
      const int r = tid >> 3, cp = tid & 7, c = hf ? 63 - r : r;
      *(u32x4*)(hb + LQS + c * 144 + cp * 16) = zr[0];
      *(u32x4*)(hb + LKB + c * 144 + cp * 16) = zr[1];
      *(u32x4*)(hb + LVB + c * 144 + cp * 16) = zr[2];
    }
    if (lw == 0) {
      const int c = lane;
      const float ad = gad + dtb;
      float sp = ad > 20.f ? ad : log1pf(expf(ad));
      float g = alog * sp;
      float bt = 1.f / (1.f + expf(-gab));
      float gc = g;
#pragma unroll
      for (int o = 1; o < 64; o <<= 1) { float v = __shfl_up(gc, o); if (lane >= o) gc += v; }
      float gl = __shfl(gc, 63);
      const float egc_ = expf(gc);
      sm[c] = gc; sm[64 + c] = bt; sm[128 + c] = egc_; sm[192 + c] = expf(gl - gc); sm[256 + c] = bt; sm[320 + c] = bt * egc_;
    }
    __syncthreads();
    {
#pragma unroll
      for (int k = 0; k < 2; ++k) {
        const int jt = 2 * wh + k;
        f32x4 dk = mma_nt64(hb + LKB, hb + LKB, wq * 16, jt * 16, fr, fq, f32x4{0.f, 0.f, 0.f, 0.f});
        int s = jt * 16 + fr;
        float gs = sm[s];
#pragma unroll
        for (int r = 0; r < 4; ++r) {
          int c = wq * 16 + fq * 4 + r;
          float v = s < c ? sm[64 + c] * dk[r] * __expf(sm[c] - gs) : 0.f;
          *(float*)(hb + LA + (s * 64 + (c & 3) * 16 + (c >> 2)) * 4) = v;
        }
      }
#pragma unroll
      for (int k = 0; k < 2; ++k) {
        const int it = 2 * wh + k;
        f32x4 dq = mma_nt64(hb + LKB, hb + LQS, it * 16, wq * 16, fr, fq, f32x4{0.f, 0.f, 0.f, 0.f});
        int c = wq * 16 + fr;
        float gcc = sm[c];
        float v[4];
#pragma unroll
        for (int r = 0; r < 4; ++r) {
          int s = it * 16 + fq * 4 + r;
          v[r] = s <= c ? dq[r] * __expf(gcc - sm[s]) : 0.f;
        }
        u32x2 o; o.x = pack2(v[0], v[1]); o.y = pack2(v[2], v[3]);
        *(u32x2*)(hb + LQK + c * 144 + (it * 16 + fq * 4) * 2) = o;
      }
    }
    __syncthreads();
    if (n + 1 < N) dn_prefetch(QK, VV, GB, base, hf ? N - 2 - n : n + 1, hf, h, tid, zr, gad, gab);
    {
      const int d = lane;
#pragma unroll
      for (int i = 0; i < 8; i += 2) {
        int c = lw * 8 + i;
        float k0 = bf2f(*(const u16*)(hb + LKB + c * 144 + d * 2)) * sm[192 + c];
        float k1 = bf2f(*(const u16*)(hb + LKB + (c + 1) * 144 + d * 2)) * sm[192 + c + 1];
        *(unsigned*)(hb + LKG + d * 144 + c * 2) = pack2(k0, k1);
      }
    }
    float xp[16];
    const int sj = tid >> 2, par = tid & 3;
    {
      const float* ATb = (const float*)(hb + LA) + par * 16;
      const char* rsrc = (sj < 64) ? hb + LVB + sj * 2 : hb + LKB + (sj - 64) * 2;
      const float* rs = sm + (sj < 64 ? 256 : 320);
#pragma unroll
      for (int i = 0; i < 16; ++i) xp[i] = rs[4 * i + par] * bf2f(*(const u16*)(rsrc + (4 * i + par) * 144));
#define DN_LOADA(dst, s_) _Pragma("unroll") for (int q = (((s_) >> 2) >> 2); q < 4; ++q) dst[q] = *(const float4*)(ATb + (s_) * 64 + q * 4)
#define DN_STEP(s_, Aq) do { const float xs_ = quad_bcast(xp[(s_) >> 2], (s_)); const f32x2 xs2_ = {xs_, xs_}; \
        _Pragma("unroll") for (int q = (((s_) >> 2) >> 2); q < 4; ++q) { \
          f32x2 lo_ = {xp[4 * q], xp[4 * q + 1]}, hi_ = {xp[4 * q + 2], xp[4 * q + 3]}; \
          const f32x2 al_ = {Aq[q].x, Aq[q].y}, ah_ = {Aq[q].z, Aq[q].w}; \
          lo_ = __builtin_elementwise_fma(-al_, xs2_, lo_); hi_ = __builtin_elementwise_fma(-ah_, xs2_, hi_); \
          xp[4 * q] = lo_[0]; xp[4 * q + 1] = lo_[1]; xp[4 * q + 2] = hi_[0]; xp[4 * q + 3] = hi_[1]; } } while (0)
      float4 A0[4], A1[4], A2[4], A3[4];
      DN_LOADA(A0, 0); DN_LOADA(A1, 1);
#pragma unroll
      for (int s = 0; s < 60; s += 4) {
        DN_LOADA(A2, s + 2); DN_LOADA(A3, s + 3); __builtin_amdgcn_sched_barrier(0);
        DN_STEP(s, A0); DN_STEP(s + 1, A1); __builtin_amdgcn_sched_barrier(0);
        DN_LOADA(A0, s + 4); DN_LOADA(A1, s + 5); __builtin_amdgcn_sched_barrier(0);
        DN_STEP(s + 2, A2); DN_STEP(s + 3, A3); __builtin_amdgcn_sched_barrier(0);
      }
      DN_LOADA(A2, 62); __builtin_amdgcn_sched_barrier(0);
      DN_STEP(60, A0); DN_STEP(61, A1); DN_STEP(62, A2);
    }
    if (sj < 64) {
#pragma unroll
      for (int i = 0; i < 16; ++i) *(u16*)(hb + LU2 + sj * 144 + (4 * i + par) * 2) = f2bf(xp[i]);
    } else {
#pragma unroll
      for (int i = 0; i < 16; ++i) *(u16*)(hb + LW2 + (4 * i + par) * 144 + (sj - 64) * 2) = f2bf(xp[i]);
    }
    __syncthreads();
    {
#pragma unroll
      for (int k = 0; k < 2; ++k) {
        const int ct = 2 * wh + k;
        f32x4 dd = mma_nt64(hb + LW2, hb + LST, ct * 16, wq * 16, fr, fq, f32x4{0.f, 0.f, 0.f, 0.f});
        int e = wq * 16 + fr;
        u32x2 u0 = *(const u32x2*)(hb + LU2 + e * 144 + (ct * 16 + fq * 4) * 2);
        float v0 = __uint_as_float(u0.x << 16) - dd[0], v1 = __uint_as_float(u0.x & 0xffff0000u) - dd[1];
        float v2 = __uint_as_float(u0.y << 16) - dd[2], v3 = __uint_as_float(u0.y & 0xffff0000u) - dd[3];
        u32x2 o; o.x = pack2(v0, v1); o.y = pack2(v2, v3);
        *(u32x2*)(hb + LA + e * 144 + (ct * 16 + fq * 4) * 2) = o;
      }
    }
    __syncthreads();
    {
      const int c = wq * 16 + fr;
      const float egc = sm[128 + c];
      const int tk = base + mch * 64 + (hf ? 63 - c : c);
#pragma unroll
      for (int k = 0; k < 2; ++k) {
        const int et = 2 * wh + k;
        f32x4 o = mma_nt64(hb + LST, hb + LQS, et * 16, wq * 16, fr, fq, f32x4{0.f, 0.f, 0.f, 0.f});
        o *= egc;
        o = mma_nt64(hb + LA, hb + LQK, et * 16, wq * 16, fr, fq, o);
        { u32x2 ov; ov.x = pack2(o[0], o[1]); ov.y = pack2(o[2], o[3]); *(u32x2*)(OB + (size_t)tk * 512 + h * 64 + et * 16 + fq * 4) = ov; }
      }
      const float egl = sm[128 + 63];
#pragma unroll
      for (int k = 0; k < 2; ++k) {
        const int dt = 2 * wh + k;
        sacc[k] *= egl;
        sacc[k] = mma_nt64(hb + LKG, hb + LA, dt * 16, wq * 16, fr, fq, sacc[k]);
      }
    }
    __syncthreads();
#pragma unroll
    for (int k = 0; k < 2; ++k) {
      const int dt = 2 * wh + k;
      u32x2 o; o.x = pack2(sacc[k][0], sacc[k][1]); o.y = pack2(sacc[k][2], sacc[k][3]);
      *(u32x2*)(hb + LST + (wq * 16 + fr) * 144 + (dt * 16 + fq * 4) * 2) = o;
    }
  }
  if (!sample) {
    const int tid = ltid(wv), lw = tid >> 6, lane = tid & 63, fr = lane & 15, fq = lane >> 4;
    float* so = p.out + OUT_S + (((size_t)seq * 2 + hf) * 8 + h) * 4096;
#pragma unroll
    for (int k = 0; k < 2; ++k)
#pragma unroll
      for (int r = 0; r < 4; ++r) so[((2 * (lw >> 2) + k) * 16 + fq * 4 + r) * 64 + (lw & 3) * 16 + fr] = sacc[k][r];
  }
  __syncthreads();
}

DI f32x16 mma32(bf16x8 a, bf16x8 b, f32x16 c) { return __builtin_amdgcn_mfma_f32_32x32x16_bf16(a, b, c, 0, 0, 0); }

DI void attn_item(const P& p, int item, int wv) {
  const int tid = ltid(wv), wid = tid >> 6, lane = tid & 63, r = lane & 31, h = lane >> 5;
  int b, head, qb, nk, tokbase;
  const u16* Kg; const u16* Vg;
  if (item < 64) {
    b = item >> 4; head = (item >> 2) & 3; qb = item & 3; nk = 1280; tokbase = T_P + b * 1024 + qb * 256;
    Kg = (const u16*)(p.ws + OFF_KS) + (size_t)b * 1280 * 512 + head * 128;
    Vg = (const u16*)(p.ws + OFF_VTS) + (size_t)b * 1280 * 512 + head * 128;
  } else {
    int id = item - 64; b = id >> 2; head = id & 3; qb = 0; nk = 256; tokbase = b * 256;
    Kg = (const u16*)(p.ws + OFF_KP) + (size_t)b * 256 * 512 + head * 128;
    Vg = (const u16*)(p.ws + OFF_VTP) + (size_t)b * 256 * 512 + head * 128;
  }
  float s1 = wave_sum(p.lq1[lane] * p.lk1[lane]);
  float s2 = wave_sum(p.lq2[lane] * p.lk2[lane]);
  const float lam = expf(s1) - expf(s2) + 0.2f;
  const int tq = tokbase + wid * 32 + r;
  const u16* Qg = (const u16*)(p.ws + OFF_Q) + (size_t)tq * 512 + head * 128;
  bf16x8 q[2][4];
#pragma unroll
  for (int mp = 0; mp < 2; ++mp)
#pragma unroll
    for (int ks = 0; ks < 4; ++ks) q[mp][ks] = *(const bf16x8*)(Qg + mp * 64 + ks * 16 + 8 * h);
  const int ntile = nk >> 6;
  float m0 = -1e30f, m1 = -1e30f, l0 = 0.f, l1 = 0.f;
  u32x4 kr[2];
  {
#pragma unroll
    for (int i = 0; i < 2; ++i) { int id = tid + 512 * i; int row = id >> 4, cp = id & 15;
      kr[i] = *(const u32x4*)(Kg + (size_t)row * 512 + cp * 8); }
  }
  __syncthreads();
  for (int t = 0; t < ntile; ++t) {
    char* KT = dsm + (t & 1) * 36864;
#pragma unroll
    for (int i = 0; i < 2; ++i) { int id = tid + 512 * i; int row = id >> 4, cp = id & 15;
      *(u32x4*)(KT + row * 272 + cp * 16) = kr[i]; }
    __syncthreads();
    if (t + 1 < ntile) {
#pragma unroll
      for (int i = 0; i < 2; ++i) { int id = tid + 512 * i; int row = id >> 4, cp = id & 15;
        kr[i] = *(const u32x4*)(Kg + (size_t)((t + 1) * 64 + row) * 512 + cp * 8); }
    }
#pragma unroll
    for (int kb2 = 0; kb2 < 2; ++kb2) {
      f32x16 sa = {}, sb = {};
#pragma unroll
      for (int ks = 0; ks < 4; ++ks) {
        bf16x8 a0 = *(const bf16x8*)(KT + (kb2 * 32 + r) * 272 + (ks * 16 + 8 * h) * 2);
        bf16x8 a1 = *(const bf16x8*)(KT + (kb2 * 32 + r) * 272 + (64 + ks * 16 + 8 * h) * 2);
        sa = mma32(a0, q[0][ks], sa); sb = mma32(a1, q[1][ks], sb);
      }
      float mx0 = sa[0], mx1 = sb[0];
#pragma unroll
      for (int i = 1; i < 16; ++i) { mx0 = fmaxf(mx0, sa[i]); mx1 = fmaxf(mx1, sb[i]); }
      float n0 = fmaxf(m0, mx0), n1 = fmaxf(m1, mx1);
      f32x2 acc0 = {0.f, 0.f}, acc1 = {0.f, 0.f};
      const f32x2 nn0 = {n0, n0}, nn1 = {n1, n1};
#pragma unroll
      for (int i = 0; i < 16; i += 2) {
        f32x2 d0 = f32x2{sa[i], sa[i + 1]} - nn0, d1 = f32x2{sb[i], sb[i + 1]} - nn1;
        acc0 += f32x2{__builtin_amdgcn_exp2f(d0[0]), __builtin_amdgcn_exp2f(d0[1])};
        acc1 += f32x2{__builtin_amdgcn_exp2f(d1[0]), __builtin_amdgcn_exp2f(d1[1])};
      }
      const float a0 = acc0[0] + acc0[1], a1 = acc1[0] + acc1[1];
      l0 = l0 * __builtin_amdgcn_exp2f(m0 - n0) + a0; l1 = l1 * __builtin_amdgcn_exp2f(m1 - n1) + a1;
      m0 = n0; m1 = n1;
    }
  }
  {
    float mo0 = __shfl_xor(m0, 32), lo0 = __shfl_xor(l0, 32), mo1 = __shfl_xor(m1, 32), lo1 = __shfl_xor(l1, 32);
    float M0 = fmaxf(m0, mo0), M1 = fmaxf(m1, mo1);
    l0 = l0 * __builtin_amdgcn_exp2f(m0 - M0) + lo0 * __builtin_amdgcn_exp2f(mo0 - M0);
    l1 = l1 * __builtin_amdgcn_exp2f(m1 - M1) + lo1 * __builtin_amdgcn_exp2f(mo1 - M1);
    m0 = M0; m1 = M1;
  }
  const float f0 = m0 + __log2f(l0);
  const float f1 = m1 + __log2f(l1) - __log2f(fmaxf(fabsf(lam), 1e-30f));
  const float sg = lam < 0.f ? -1.f : 1.f;
  f32x16 oacc[4] = {};
  u32x4 vr[2];
  {
#pragma unroll
    for (int i = 0; i < 2; ++i) { int id = tid + 512 * i; int row = id >> 4, cp = id & 15;
      kr[i] = *(const u32x4*)(Kg + (size_t)row * 512 + cp * 8);
      int vkey = id & 63, vcp = id >> 6;
      vr[i] = *(const u32x4*)(Vg + (size_t)vkey * 512 + vcp * 8); }
  }
  __syncthreads();
  for (int t = 0; t < ntile; ++t) {
    char* KT = dsm + (t & 1) * 36864;
    char* VT = KT + 17408;
#pragma unroll
    for (int i = 0; i < 2; ++i) { int id = tid + 512 * i; int row = id >> 4, cp = id & 15;
      *(u32x4*)(KT + row * 272 + cp * 16) = kr[i];
      int vkey = id & 63, vcp = id >> 6;
      const unsigned vw[4] = {vr[i].x, vr[i].y, vr[i].z, vr[i].w};
#pragma unroll
      for (int j = 0; j < 4; ++j) {
        *(u16*)(VT + (vcp * 8 + 2 * j) * 144 + vkey * 2) = (u16)(vw[j] & 0xffffu);
        *(u16*)(VT + (vcp * 8 + 2 * j + 1) * 144 + vkey * 2) = (u16)(vw[j] >> 16);
      } }
    __syncthreads();
    if (t + 1 < ntile) {
#pragma unroll
      for (int i = 0; i < 2; ++i) { int id = tid + 512 * i; int row = id >> 4, cp = id & 15;
        kr[i] = *(const u32x4*)(Kg + (size_t)((t + 1) * 64 + row) * 512 + cp * 8);
        int vkey = id & 63, vcp = id >> 6;
        vr[i] = *(const u32x4*)(Vg + (size_t)((t + 1) * 64 + vkey) * 512 + vcp * 8); }
    }
#pragma unroll
    for (int kb2 = 0; kb2 < 2; ++kb2) {
      f32x16 sa = {}, sb = {};
#pragma unroll
      for (int ks = 0; ks < 4; ++ks) {
        bf16x8 a0 = *(const bf16x8*)(KT + (kb2 * 32 + r) * 272 + (ks * 16 + 8 * h) * 2);
        bf16x8 a1 = *(const bf16x8*)(KT + (kb2 * 32 + r) * 272 + (64 + ks * 16 + 8 * h) * 2);
        sa = mma32(a0, q[0][ks], sa); sb = mma32(a1, q[1][ks], sb);
      }
      float av[16];
      {
        const f32x2 ff0 = {f0, f0}, ff1 = {f1, f1}, nsg = {-sg, -sg};
#pragma unroll
        for (int i = 0; i < 16; i += 2) {
          f32x2 d0 = f32x2{sa[i], sa[i + 1]} - ff0, d1 = f32x2{sb[i], sb[i + 1]} - ff1;
          f32x2 e0 = {__builtin_amdgcn_exp2f(d0[0]), __builtin_amdgcn_exp2f(d0[1])};
          f32x2 e1 = {__builtin_amdgcn_exp2f(d1[0]), __builtin_amdgcn_exp2f(d1[1])};
          f32x2 r = __builtin_elementwise_fma(nsg, e1, e0);
          av[i] = r[0]; av[i + 1] = r[1];
        }
      }
#pragma unroll
      for (int s = 0; s < 2; ++s) {
        u32x4 pp;
        pp.x = pack2(av[8 * s], av[8 * s + 1]); pp.y = pack2(av[8 * s + 2], av[8 * s + 3]);
        pp.z = pack2(av[8 * s + 4], av[8 * s + 5]); pp.w = pack2(av[8 * s + 6], av[8 * s + 7]);
        bf16x8 pb = __builtin_bit_cast(bf16x8, pp);
#pragma unroll
        for (int dvb = 0; dvb < 4; ++dvb) {
          const char* vp = VT + (dvb * 32 + r) * 144 + (kb2 * 32 + 16 * s + 4 * h) * 2;
          u32x2 lo = *(const u32x2*)(vp), hi = *(const u32x2*)(vp + 16);
          u32x4 vv; vv.x = lo.x; vv.y = lo.y; vv.z = hi.x; vv.w = hi.y;
          oacc[dvb] = mma32(__builtin_bit_cast(bf16x8, vv), pb, oacc[dvb]);
        }
      }
    }
  }
  float ss = 0.f;
#pragma unroll
  for (int dvb = 0; dvb < 4; ++dvb)
#pragma unroll
    for (int i = 0; i < 16; ++i) ss += oacc[dvb][i] * oacc[dvb][i];
  ss += __shfl_xor(ss, 32);
  const float rstd = rsqrtf(ss * (1.f / 128.f) + 1e-6f) * 0.8f;
  u16* MIX = (u16*)(p.ws + OFF_MIX) + (size_t)tq * 1024 + 512 + head * 128;
#pragma unroll
  for (int dvb = 0; dvb < 4; ++dvb)
#pragma unroll
    for (int g = 0; g < 4; ++g) {
      int dv = dvb * 32 + 8 * g + 4 * h;
      float4 dn = *(const float4*)(p.diff_norm + dv);
      u32x2 o;
      o.x = pack2(oacc[dvb][4 * g] * rstd * dn.x, oacc[dvb][4 * g + 1] * rstd * dn.y);
      o.y = pack2(oacc[dvb][4 * g + 2] * rstd * dn.z, oacc[dvb][4 * g + 3] * rstd * dn.w);
      *(u32x2*)(MIX + dv) = o;
    }
  __syncthreads();
}

DI void mixer_phase(CP pp, int wv, int rep) {
  const P p = ldp(pp);
  int* ctr = (int*)(p.ws + OFF_CTR) + rep;
  int* cur = (int*)(dsm + LDS_BYTES - 16);
  while (true) {
    __syncthreads();
    if (ltid(wv) == 0) *cur = atomicAdd(ctr, 1);
    __syncthreads();
    int it = *cur;
    __syncthreads();
    if (it >= 768 + 592) break;
    if (it >= 768) {
      const int id = it - 768;
      if (id < 64) transpose_tile(p.w_out, 1024, (u16*)(p.ws + OFF_WB4), 1024, (id % 4) * 256, (id / 4) * 64, 0, wv);
      else if (id < 64 + 352) { const int j = id - 64; transpose_tile(p.w_ffn2_in, 5632, (u16*)(p.ws + OFF_WB5), 1024, (j % 22) * 256, (j / 22) * 64, 1, wv); }
      else { const int j = id - 416; transpose_tile(p.w_ffn2_out, 1024, (u16*)(p.ws + OFF_WB6), DFF, (j % 4) * 256, (j / 4) * 64, 0, wv); }
      continue;
    }
    if (it < 64) { for (int r2 = 0; r2 < DN_REP; ++r2) deltanet_item(p, 512 + it, wv); }
    else if (it < 128) { for (int r2 = 0; r2 < AT_REP; ++r2) attn_item(p, it - 64, wv); }
    else if (it < 640) { for (int r2 = 0; r2 < DN_REP; ++r2) deltanet_item(p, it - 128, wv); }
    else { for (int r2 = 0; r2 < AT_REP; ++r2) attn_item(p, it - 640 + 64, wv); }
  }
}

DI void combine_phase(CP pp, int wv) {
  const P p = ldp(pp);
  const int tidc = ltid(wv), lane = tidc & 63, wid = tidc >> 6;
  const u16* OB = (const u16*)(p.ws + OFF_HID);
  const u16* ZA = (const u16*)(p.ws + OFF_ZA);
  u16* MIX = (u16*)(p.ws + OFF_MIX);
  const int e0 = (lane & 7) * 8;
  const float4 dn0 = *(const float4*)(p.delta_norm + e0), dn1 = *(const float4*)(p.delta_norm + e0 + 4);
  for (int w = blockIdx.x * 8 + wid; w < 2048; w += gridDim.x * 8)
  for (int half = 0; half < 1; ++half) {
    u32x4 a[6][2]; u32x4 z[6];
#pragma unroll
    for (int rr = 0; rr < 6; ++rr) {
      const int t = w * 6 + rr;
      const size_t idx = (size_t)t * 512 + lane * 8;
      a[rr][0] = *(const u32x4*)(OB + idx);
      a[rr][1] = *(const u32x4*)(OB + (size_t)T_TOK * 512 + idx);
      z[rr] = *(const u32x4*)(ZA + (size_t)t * 2048 + 1536 + lane * 8);
    }
#pragma unroll
    for (int rr = 0; rr < 6; ++rr) {
      const int t = w * 6 + rr;
      float o[8];
      {
        const unsigned fa[4] = {a[rr][0].x, a[rr][0].y, a[rr][0].z, a[rr][0].w}, fb[4] = {a[rr][1].x, a[rr][1].y, a[rr][1].z, a[rr][1].w};
#pragma unroll
        for (int i = 0; i < 4; ++i) {
          o[2 * i] = __uint_as_float(fa[i] << 16) + __uint_as_float(fb[i] << 16);
          o[2 * i + 1] = __uint_as_float(fa[i] & 0xffff0000u) + __uint_as_float(fb[i] & 0xffff0000u);
        }
      }
      float ss = 0.f;
#pragma unroll
      for (int i = 0; i < 8; ++i) ss += o[i] * o[i];
      ss = oct_sum(ss);
      const float rstd = rsqrtf(ss * (1.f / 64.f) + 1e-6f);
      const float dnv[8] = {dn0.x, dn0.y, dn0.z, dn0.w, dn1.x, dn1.y, dn1.z, dn1.w};
      const unsigned zz[4] = {z[rr].x, z[rr].y, z[rr].z, z[rr].w};
      float y[8];
#pragma unroll
      for (int i = 0; i < 8; ++i) {
        float zv = (i & 1) ? __uint_as_float(zz[i >> 1] & 0xffff0000u) : __uint_as_float(zz[i >> 1] << 16);
        y[i] = o[i] * rstd * dnv[i] * siluf(zv);
      }
      u32x4 r; r.x = pack2(y[0], y[1]); r.y = pack2(y[2], y[3]); r.z = pack2(y[4], y[5]); r.w = pack2(y[6], y[7]);
      *(u32x4*)(MIX + (size_t)t * 1024 + lane * 8) = r;
    }
  }
}

DI void deferred_w23(CP pp, int wv) {
  const P p = ldp(pp);
  const int ntiles = 48 * 22, rem = ntiles % (int)gridDim.x;
  int first, stride;
  if (rem == 0) { first = blockIdx.x; stride = gridDim.x; }
  else { if ((int)blockIdx.x < rem) return; first = blockIdx.x - rem; stride = gridDim.x - rem; }
  for (int id = first; id < 176 + 240; id += stride) {
    if (id < 176) transpose_tile(p.w_ffn1_out, 1024, (u16*)(p.ws + OFF_WB2), DFF, (id % 4) * 256, (id / 4) * 64, 0, wv);
    else { const int j = id - 176; transpose_tile(p.w_in, 3616, (u16*)(p.ws + OFF_WB3), 1024, (j % 15) * 256, (j / 15) * 64, 2, wv); }
  }
  phase0(pp, wv, first, stride);
}

DI void gemm_dispatch(CP pp, int wv, int which) {
  const P p = ldp(pp);
  const u16* XN = (const u16*)(p.ws + OFF_XN);
  u16* HID = (u16*)(p.ws + OFF_HID);
  const float* MOD = (const float*)(p.ws + OFF_MOD);
  float* Y = p.out + OUT_Y;
  switch (which) {
    case 2: gemm_phase<4>(XN, (const u16*)(p.ws + OFF_WB1), 1024, 48, 22, EpiSwiGLU{HID}, wv); break;
    case 3: gemm_phase<3>(HID, (const u16*)(p.ws + OFF_WB2), DFF, 64, 4, EpiResid192{p.x_prompt, p.x_sample, Y, MOD, 2, 0.5f}, wv); break;
    case 5: gemm_phase<4>(XN, (const u16*)(p.ws + OFF_WB3), 1024, 48, 15, EpiInProj{p.ws, p.out}, wv); break;
    case 8: gemm_phase<3>((const u16*)(p.ws + OFF_MIX), (const u16*)(p.ws + OFF_WB4), 1024, 64, 4, EpiResid192{Y, Y + (size_t)T_P * 1024, Y, MOD, 5, 1.0f}, wv); break;
    case 10: gemm_phase<4>(XN, (const u16*)(p.ws + OFF_WB5), 1024, 48, 22, EpiSwiGLU{HID}, wv); break;
    case 11: gemm_phase<3>(HID, (const u16*)(p.ws + OFF_WB6), DFF, 64, 4, EpiResid192{Y, Y + (size_t)T_P * 1024, Y, MOD, 8, 0.5f}, wv); break;
  }
}

__global__ void __launch_bounds__(512, 2) mega(P pv) {
  cg::grid_group grid = cg::this_grid();
  CP pp = (CP)__builtin_amdgcn_kernarg_segment_ptr();
  const int wv = __builtin_amdgcn_readfirstlane(threadIdx.x >> 6);
  const int plo = pp->plo, phi = pp->phi;
  if (phi > 1000) grid.sync();
  gbar_post(pp, wv);
#ifdef EXTRA_SYNCS
  for (int i = 0; i < EXTRA_SYNCS; ++i) gbar(pp, wv);
#endif
  for (int ph = plo; ph <= phi; ++ph) {
    const int reps = ((REPEAT_MASK >> ph) & 1) ? 2 : 1;
    for (int rep = 0; rep < reps; ++rep) {
    if (ph > plo || rep > 0) gbar(pp, wv);
    switch (ph) {
      case 0: phase0(pp, wv); break;
      case 1: norm_phase<0>(pp, wv); break;
      case 4: norm_phase<1>(pp, wv); break;
      case 6: conv_phase(pp, wv); gbar(pp, wv); mixer_phase(pp, wv, rep); break;
      case 7: combine_phase(pp, wv); break;
      case 9: norm_phase<2>(pp, wv); break;
      case 12: norm_phase<3>(pp, wv); break;
      default: gemm_dispatch(pp, wv, ph); if (ph == 2 && rep == 0) deferred_w23(pp, wv); break;
    }
    }
  }
}

extern "C" void kernel_launch(void* const* d_in, const int* in_sizes, int n_in, void* d_out, int out_size,
                              void* d_ws, size_t ws_size, hipStream_t stream) {
  static int grid_blocks = 0;
  if (!grid_blocks) {
    int dev = 0, cus = 0, per_cu = 0;
    hipGetDevice(&dev);
    hipDeviceGetAttribute(&cus, hipDeviceAttributeMultiprocessorCount, dev);
    hipFuncSetAttribute((const void*)mega, hipFuncAttributeMaxDynamicSharedMemorySize, LDS_BYTES);
    hipOccupancyMaxActiveBlocksPerMultiprocessor(&per_cu, (const void*)mega, 512, LDS_BYTES);
    if (per_cu < 1) per_cu = 1;
    grid_blocks = cus * per_cu;
    if (grid_blocks > 256) grid_blocks = 256;
    grid_blocks &= ~7;
    if (ws_size < WS_END) fprintf(stderr, "workspace too small: %zu < %zu\n", ws_size, (size_t)WS_END);
  }
  hipMemsetAsync((char*)d_ws + OFF_BAR, 0, 16384, stream);
  P p{};
  const float** f = (const float**)&p;
  for (int i = 0; i < 28; ++i) f[i] = (const float*)d_in[i];
  p.out = (float*)d_out; p.ws = (char*)d_ws;
#if MK_MULTI
  for (int ph = 0; ph <= 12; ++ph) {
    p.plo = ph; p.phi = ph;
    hipLaunchKernelGGL(mega, dim3(grid_blocks), dim3(512), LDS_BYTES, stream, p);
  }
#else
  p.plo = 0; p.phi = 12;
  void* args[] = {&p};
  hipError_t e = hipLaunchCooperativeKernel((const void*)mega, dim3(grid_blocks), dim3(512), args, LDS_BYTES, stream);
  if (e != hipSuccess) fprintf(stderr, "cooperative launch failed: %s (grid %d)\n", hipGetErrorString(e), grid_blocks);
#endif
}
```

```cpp
#include <hip/hip_runtime.h>
#include <hip/hip_cooperative_groups.h>
#include <cstdio>
namespace cg = cooperative_groups;

#ifndef DN_REP
#define DN_REP 1
#endif
#ifndef AT_REP
#define AT_REP 1
#endif
#ifndef REPEAT_MASK
#define REPEAT_MASK 0
#endif
#ifndef MK_MULTI
#define MK_MULTI 0
#endif

#define DI __device__ __forceinline__
typedef unsigned short u16;
using bf16x8 = __attribute__((ext_vector_type(8))) short;
using s16x4  = __attribute__((ext_vector_type(4))) short;
using f32x4  = __attribute__((ext_vector_type(4))) float;
using f32x2  = __attribute__((ext_vector_type(2))) float;
using f32x16 = __attribute__((ext_vector_type(16))) float;
using u32x2  = __attribute__((ext_vector_type(2))) unsigned;
using u32x4  = __attribute__((ext_vector_type(4))) unsigned;

extern __shared__ __attribute__((aligned(16))) char dsm[];

constexpr int T_TOK = 12288, T_P = 8192, DM = 1024, DFF = 2816;
constexpr int NKS = 16;
constexpr int LDS_BYTES = 131072 + 64;

constexpr size_t OFF_WB1 = 0;
constexpr size_t OFF_WB2 = OFF_WB1 + 11534336;
constexpr size_t OFF_WB3 = OFF_WB2 + 5767168;
constexpr size_t OFF_WB4 = OFF_WB3 + 7864320;
constexpr size_t OFF_WB5 = OFF_WB4 + 2097152;
constexpr size_t OFF_WB6 = OFF_WB5 + 11534336;
constexpr size_t OFF_MODP = OFF_WB6 + 5767168;
constexpr size_t OFF_MOD = OFF_MODP + (size_t)NKS * 5 * 9216 * 4;
constexpr size_t OFF_ROPE = OFF_MOD + 5 * 9216 * 4;
constexpr size_t OFF_CTR = OFF_ROPE + 8192;
constexpr size_t OFF_GB = OFF_CTR + 256;
constexpr size_t OFF_XN = OFF_GB + (size_t)T_TOK * 32 * 4;
constexpr size_t OFF_MIX = OFF_XN + (size_t)T_TOK * 1024 * 2;
constexpr size_t OFF_HID = OFF_MIX + (size_t)T_TOK * 1024 * 2;
constexpr size_t OFF_ZA = OFF_HID + (size_t)T_TOK * DFF * 2;
constexpr size_t OFF_Q = OFF_ZA + (size_t)T_TOK * 2048 * 2;
constexpr size_t OFF_KP = OFF_Q + (size_t)T_TOK * 512 * 2;
constexpr size_t OFF_KS = OFF_KP + (size_t)T_P * 512 * 2;
constexpr size_t OFF_VTP = OFF_KS + (size_t)4 * 1280 * 512 * 2;
constexpr size_t OFF_VTS = OFF_VTP + (size_t)T_P * 512 * 2;
constexpr size_t OFF_BAR = OFF_VTS + (size_t)4 * 1280 * 512 * 2;
constexpr size_t WS_END = OFF_BAR + 16384;

constexpr size_t OUT_Y = 0;
constexpr size_t OUT_K = 12582912;
constexpr size_t OUT_V = 16777216;
constexpr size_t OUT_S = 20971520;

struct P {
  const float *x_prompt, *x_sample, *cache_k, *cache_v, *state, *c, *c_ctx, *w_ada, *b_ada,
      *norm_ffn1, *w_ffn1_in, *w_ffn1_out, *norm_mix, *w_in, *conv_w, *a_log, *dt_bias, *delta_norm,
      *lq1, *lk1, *lq2, *lk2, *diff_norm, *w_out, *norm_ffn2, *w_ffn2_in, *w_ffn2_out, *norm_final;
  float* out;
  char* ws;
  int plo, phi;
};

DI u16 f2bf(float x) { return __builtin_bit_cast(u16, (__bf16)x); }
DI float bf2f(u16 b) { return __uint_as_float(((unsigned)b) << 16); }
DI unsigned pack2(float a, float b) { return (unsigned)f2bf(a) | ((unsigned)f2bf(b) << 16); }
#define DPPF(v, ctrl, rmask) __int_as_float(__builtin_amdgcn_update_dpp(0, __float_as_int(v), ctrl, rmask, 0xf, false))
DI float wave_sum(float v) {
  v += DPPF(v, 0xB1, 0xf); v += DPPF(v, 0x4E, 0xf); v += DPPF(v, 0x141, 0xf); v += DPPF(v, 0x140, 0xf);
  v += DPPF(v, 0x142, 0xa); v += DPPF(v, 0x143, 0xc);
  return __int_as_float(__builtin_amdgcn_readlane(__float_as_int(v), 63));
}
DI float quad_bcast(float v, int k) {
  switch (k & 3) {
    case 0: return DPPF(v, 0x00, 0xf);
    case 1: return DPPF(v, 0x55, 0xf);
    case 2: return DPPF(v, 0xAA, 0xf);
    default: return DPPF(v, 0xFF, 0xf);
  }
}
DI float oct_sum(float v) {
  v += DPPF(v, 0xB1, 0xf); v += DPPF(v, 0x4E, 0xf); v += DPPF(v, 0x141, 0xf);
  return v;
}
typedef const P __attribute__((address_space(4)))* CP;
typedef const unsigned long long __attribute__((address_space(4)))* CU64;
DI int ltid(int wv) { unsigned m = ~0u; asm volatile("" : "+s"(m)); int t = wv * 64 + (int)__builtin_amdgcn_mbcnt_hi(m, __builtin_amdgcn_mbcnt_lo(m, 0u)); asm volatile("" : "+v"(t)); return t; }
DI P ldp(CP pp) {
  asm volatile("" : "+s"(pp));
  P p; CU64 s = (CU64)pp; unsigned long long* d = (unsigned long long*)&p;
#pragma unroll
  for (int i = 0; i < 31; ++i) d[i] = s[i];
  return p;
}

#define XB_TMO      128
#define XB_XCNT(j)  (256  + 64 * (j))
#define XB_XSUB(j)  (1280 + 64 * (j))
#define XB_XGEN(j)  (2304 + 64 * (j))
#define XB_TOP      3328
#define XB_TOPGEN   3392
#define XCD_BAR_WORDS 3456
#define XB_SPIN_CAP (1u << 20)
DI unsigned xb_ld(unsigned* p) { return __hip_atomic_load(p, __ATOMIC_RELAXED, __HIP_MEMORY_SCOPE_AGENT); }
DI unsigned xb_add(unsigned* p, unsigned v) { return __hip_atomic_fetch_add(p, v, __ATOMIC_RELAXED, __HIP_MEMORY_SCOPE_AGENT); }
DI unsigned xb_xcc_id() { return (unsigned)__builtin_amdgcn_s_getreg((3 << 11) | 20) & 0xFu; }
#define XB_SPIN(cond, bar) do { unsigned _sp = 0; while (cond) { __builtin_amdgcn_s_sleep(1); \
    if ((++_sp & 255u) == 0u) { if (xb_ld(&(bar)[XB_TMO])) break; if (_sp > XB_SPIN_CAP) { atomicAdd(&(bar)[XB_TMO], 1u); break; } } } } while (0)
DI void xcd_barrier_complete(unsigned* bar, unsigned x, unsigned& nloc, unsigned& nx) {
  const unsigned G = gridDim.x;
  unsigned sum, cnt, mine, sp = 0u;
  for (;;) {
    sum = 0u; cnt = 0u; mine = 0u;
#pragma unroll
    for (unsigned j = 0; j < 16; ++j) { const unsigned c = xb_ld(&bar[XB_XCNT(j)]); sum += c; cnt += (c > 0u) ? 1u : 0u; mine = (j == x) ? c : mine; }
    if (sum == G) break;
    __builtin_amdgcn_s_sleep(1);
    if ((++sp & 255u) == 0u) { if (xb_ld(&bar[XB_TMO])) break; if (sp > XB_SPIN_CAP) { atomicAdd(&bar[XB_TMO], 1u); break; } }
  }
  nloc = mine > 0u ? mine : 1u; nx = cnt > 0u ? cnt : 1u;
}
DI void gbar_post(CP pp, int wv) {
  volatile unsigned* st = (volatile unsigned*)(dsm + LDS_BYTES - 32);
  if (ltid(wv) == 0) {
    unsigned* bar = (unsigned*)(pp->ws + OFF_BAR);
    st[0] = 0u; st[1] = 0u;
    (void)xb_add(&bar[XB_XCNT(xb_xcc_id())], 1u);
  }
  __syncthreads();
}
DI void gbar(CP pp, int wv) {
  asm volatile("s_waitcnt vmcnt(0)" ::: "memory");
  __syncthreads();
  if (ltid(wv) == 0) {
    unsigned* bar = (unsigned*)(pp->ws + OFF_BAR);
    volatile unsigned* st = (volatile unsigned*)(dsm + LDS_BYTES - 32);
    const unsigned x = xb_xcc_id();
    __builtin_amdgcn_s_waitcnt(0);
    unsigned nloc = st[0], nx = st[1];
    if (nloc == 0u) { xcd_barrier_complete(bar, x, nloc, nx); st[0] = nloc; st[1] = nx; }
    const unsigned old = xb_add(&bar[XB_XSUB(x)], 1u);
    const unsigned gen = old / nloc;
    if (old + 1u == (gen + 1u) * nloc) {
      __builtin_amdgcn_fence(__ATOMIC_RELEASE, "agent");
      asm volatile("s_waitcnt vmcnt(0)" ::: "memory");
      const unsigned og = xb_add(&bar[XB_TOP], 1u);
      const unsigned tg = og / nx;
      if (og + 1u == (tg + 1u) * nx) xb_add(&bar[XB_TOPGEN], 1u);
      else XB_SPIN(xb_ld(&bar[XB_TOPGEN]) == tg, bar);
      __builtin_amdgcn_fence(__ATOMIC_ACQUIRE, "agent");
      xb_add(&bar[XB_XGEN(x)], 1u);
      asm volatile("s_waitcnt vmcnt(0)" ::: "memory");
    } else {
      XB_SPIN(xb_ld(&bar[XB_XGEN(x)]) == gen, bar);
      __builtin_amdgcn_fence(__ATOMIC_ACQUIRE, "agent");
      asm volatile("s_waitcnt vmcnt(0)" ::: "memory");
    }
  }
  __syncthreads();
}
DI float4 nt_load4(const float* p) { f32x4 v = __builtin_nontemporal_load((const f32x4*)p); return make_float4(v[0], v[1], v[2], v[3]); }
DI void nt_store4(float4 v, float* p) { f32x4 t = {v.x, v.y, v.z, v.w}; __builtin_nontemporal_store(t, (f32x4*)p); }
DI float siluf(float x) { return x * __builtin_amdgcn_rcpf(1.f + __builtin_amdgcn_exp2f(-1.4426950408889634f * x)); }
DI int tok_group(int t) { return t < T_P ? 0 : 1 + ((t - T_P) >> 10); }

DI void transpose_tile(const float* __restrict__ src, int nsrc, u16* __restrict__ dst, int K, int n0, int k0, int mode, int wv) {
  float* tl = (float*)dsm;
  const int tid = ltid(wv);
  float4 v[8];
#pragma unroll
  for (int i = 0; i < 8; ++i) {
    int e = tid + 512 * i;
    int k = e >> 6, n = n0 + (e & 63) * 4, sc;
    if (mode == 1 || (mode == 2 && (n < 2048 || (n >= 3072 && n < 3584)))) { const int rho = n & 31, nf = rho >> 4, i = rho & 15; n = (n & ~31) + 8 * (i >> 2) + 4 * nf + (i & 3); }
    if (mode == 1) { int pp = n >> 8, w = n & 255; sc = (w >> 7) * DFF + pp * 128 + (w & 127); }
    else if (mode == 2) { sc = n < 2048 ? n : (n < 3584 ? n + 32 : (n < 3616 ? n - 3584 + 2048 : -1)); }
    else sc = n;
    v[i] = sc >= 0 ? nt_load4(src + (size_t)(k0 + k) * nsrc + sc) : make_float4(0.f, 0.f, 0.f, 0.f);
  }
#pragma unroll
  for (int i = 0; i < 8; ++i) {
    int e = tid + 512 * i;
    int k = e >> 6, j = (e & 63) * 4;
    tl[k * 257 + j] = v[i].x; tl[k * 257 + j + 1] = v[i].y; tl[k * 257 + j + 2] = v[i].z; tl[k * 257 + j + 3] = v[i].w;
  }
  __syncthreads();
#pragma unroll
  for (int i = 0; i < 8; ++i) {
    int e = tid + 512 * i;
    int n = e >> 4, kq = (e & 15) * 4;
    u32x2 o;
    o.x = pack2(tl[kq * 257 + n], tl[(kq + 1) * 257 + n]);
    o.y = pack2(tl[(kq + 2) * 257 + n], tl[(kq + 3) * 257 + n]);
    *(u32x2*)(dst + (size_t)(n0 + n) * K + k0 + kq) = o;
  }
  __syncthreads();
}

DI void phase0(CP pp, int wv, int misc_first = -1, int misc_stride = 1) {
  const P p = ldp(pp);
  const bool misc = misc_first >= 0;
  const int tid = ltid(wv);
  u16* WB1 = (u16*)(p.ws + OFF_WB1); u16* WB2 = (u16*)(p.ws + OFF_WB2); u16* WB3 = (u16*)(p.ws + OFF_WB3);
  u16* WB4 = (u16*)(p.ws + OFF_WB4); u16* WB5 = (u16*)(p.ws + OFF_WB5); u16* WB6 = (u16*)(p.ws + OFF_WB6);
  float* MODP = (float*)(p.ws + OFF_MODP);
  constexpr int NA = 256;
  constexpr int S1 = NA, S2 = S1 + 352, S3 = S2 + 176, S4 = S3 + 240, S5 = S4 + 64, S6 = S5 + 352, S7 = S6 + 176;
  constexpr int S8 = S7 + 1, S9 = S8 + 16, S10 = S9 + 16;
  for (int it = misc ? S7 + misc_first : (int)blockIdx.x; it < (misc ? S10 : S2); it += misc ? misc_stride : (int)gridDim.x) {
    if (it >= S2 && it < S7) continue;
    if (it < NA) {
      float* sl = (float*)dsm;
      float* red = sl + 5120;
      __syncthreads();
      for (int e = tid; e < 5120; e += 512) {
        int g = e >> 10, k = e & 1023;
        float v = g == 0 ? p.c_ctx[k] : p.c[(g - 1) * 1024 + k];
        sl[e] = v / (1.f + expf(-v));
      }
      __syncthreads();
      const int c0 = it * 36;
      if (tid < 504) {
        const int kg = tid / 36, col = tid - kg * 36;
        float a0 = 0, a1 = 0, a2 = 0, a3 = 0, a4 = 0;
        const float* wp = p.w_ada + c0 + col;
#pragma unroll 1
        for (int i0 = 0; i0 < 74; i0 += 19) {
          float wv_[19];
#pragma unroll
          for (int j = 0; j < 19; ++j) { const int k = kg + 14 * (i0 + j); wv_[j] = (i0 + j < 74 && k < 1024) ? __builtin_nontemporal_load(wp + (size_t)k * 9216) : 0.f; }
#pragma unroll
          for (int j = 0; j < 19; ++j) {
            const int k = min(kg + 14 * (i0 + j), 1023); const float w = wv_[j];
            a0 += sl[k] * w; a1 += sl[1024 + k] * w; a2 += sl[2048 + k] * w; a3 += sl[3072 + k] * w; a4 += sl[4096 + k] * w;
          }
        }
        float* r = red + (kg * 36 + col) * 5;
        r[0] = a0; r[1] = a1; r[2] = a2; r[3] = a3; r[4] = a4;
      }
      __syncthreads();
      if (tid < 180) {
        const int col = tid / 5, g = tid - col * 5;
        float a = p.b_ada[c0 + col];
#pragma unroll
        for (int kg = 0; kg < 14; ++kg) a += red[(kg * 36 + col) * 5 + g];
        ((float*)(p.ws + OFF_MOD))[g * 9216 + c0 + col] = a;
      }
      __syncthreads();
    } else if (it < S2) { int id = it - S1; transpose_tile(p.w_ffn1_in, 5632, WB1, 1024, (id % 22) * 256, (id / 22) * 64, 1, wv); }
    else if (it < S3) { int id = it - S2; transpose_tile(p.w_ffn1_out, 1024, WB2, DFF, (id % 4) * 256, (id / 4) * 64, 0, wv); }
    else if (it < S4) { int id = it - S3; transpose_tile(p.w_in, 3616, WB3, 1024, (id % 15) * 256, (id / 15) * 64, 2, wv); }
    else if (it < S5) { int id = it - S4; transpose_tile(p.w_out, 1024, WB4, 1024, (id % 4) * 256, (id / 4) * 64, 0, wv); }
    else if (it < S6) { int id = it - S5; transpose_tile(p.w_ffn2_in, 5632, WB5, 1024, (id % 22) * 256, (id / 22) * 64, 1, wv); }
    else if (it < S7) { int id = it - S6; transpose_tile(p.w_ffn2_out, 1024, WB6, DFF, (id % 4) * 256, (id / 4) * 64, 0, wv); }
    else if (it < S8) {
      float* rope = (float*)(p.ws + OFF_ROPE);
      for (int e = tid; e < 1024; e += 512) {
        int pos = e >> 4, i = e & 15;
        float inv = powf(10000.f, -(float)i / 16.f);
        float ang = (float)pos * inv;
        rope[e] = cosf(ang); rope[1024 + e] = sinf(ang);
      }
      if (tid < 4) ((int*)(p.ws + OFF_CTR))[tid] = 0;
    } else if (it < S9) {
      int id = it - S8;
      u16* KS = (u16*)(p.ws + OFF_KS);
      for (int e = tid; e < 64 * 256; e += 512) {
        int rr = id * 64 + (e >> 8), c2 = (e & 255) * 2;
        int b = rr >> 8, j = rr & 255;
        const float* s = p.cache_k + (size_t)rr * 512 + c2;
        const int rho = c2 & 31, cp2 = (c2 & ~31) + 8 * ((rho & 15) >> 2) + 4 * (rho >> 4) + (rho & 3);
        *(unsigned*)(KS + ((size_t)b * 1280 + j) * 512 + cp2) = pack2(s[0], s[1]);
      }
    } else {
      int id = it - S9;
      u16* VS = (u16*)(p.ws + OFF_VTS);
      for (int e = tid; e < 64 * 256; e += 512) {
        int rr = id * 64 + (e >> 8), c2 = (e & 255) * 2;
        int b = rr >> 8, j = rr & 255;
        const float* s = p.cache_v + (size_t)rr * 512 + c2;
        *(unsigned*)(VS + ((size_t)b * 1280 + j) * 512 + c2) = pack2(s[0], s[1]);
      }
    }
  }
}

template <int which>
DI void norm_phase(CP pp, int wv) {
  const P p = ldp(pp);
  const int tid = ltid(wv), lane = tid & 63, wid = tid >> 6;
  const float* MODP = (const float*)(p.ws + OFF_MODP);
  float* MOD = (float*)(p.ws + OFF_MOD);
  u16* XN = (u16*)(p.ws + OFF_XN);
  const float* gain = which == 0 ? p.norm_ffn1 : which == 1 ? p.norm_mix : which == 2 ? p.norm_ffn2 : p.norm_final;
  constexpr int s_shift = which == 0 ? 0 : which == 1 ? 3 : 6;
  float4 gn[4], sh[4], sc[4];
#pragma unroll
  for (int i = 0; i < 4; ++i) gn[i] = *(const float4*)(gain + i * 256 + lane * 4);
  int gcur = -1;
  for (int w = blockIdx.x * 8 + wid; w < 2048; w += gridDim.x * 8)
  for (int half = 0; half < 1; ++half) {
    const int t0 = w * 6;
    float4 xv[6][4];
#pragma unroll
    for (int rr = 0; rr < 6; ++rr) {
      const int t = t0 + rr;
      const float* xr = which == 0 ? (t < T_P ? p.x_prompt + (size_t)t * 1024 : p.x_sample + (size_t)(t - T_P) * 1024)
                                   : p.out + OUT_Y + (size_t)t * 1024;
#pragma unroll
      for (int i = 0; i < 4; ++i) xv[rr][i] = *(const float4*)(xr + i * 256 + lane * 4);
    }
#pragma unroll
    for (int rr = 0; rr < 6; ++rr) {
      const int t = t0 + rr;
      float ss = 0.f;
#pragma unroll
      for (int i = 0; i < 4; ++i) ss += xv[rr][i].x * xv[rr][i].x + xv[rr][i].y * xv[rr][i].y + xv[rr][i].z * xv[rr][i].z + xv[rr][i].w * xv[rr][i].w;
      ss = wave_sum(ss);
      const float rstd = rsqrtf(ss * (1.f / 1024.f) + 1e-6f);
      if (which == 3) {
        float* orow = p.out + OUT_Y + (size_t)t * 1024;
#pragma unroll
        for (int i = 0; i < 4; ++i) {
          float4 o;
          o.x = xv[rr][i].x * rstd * gn[i].x; o.y = xv[rr][i].y * rstd * gn[i].y;
          o.z = xv[rr][i].z * rstd * gn[i].z; o.w = xv[rr][i].w * rstd * gn[i].w;
          nt_store4(o, orow + i * 256 + lane * 4);
        }
      } else {
        const int g = tok_group(t);
        if (g != gcur) {
          gcur = g;
#pragma unroll
          for (int i = 0; i < 4; ++i) {
            const int col = i * 256 + lane * 4;
            {
              sh[i] = *(const float4*)(MOD + (g * 9 + s_shift) * 1024 + col);
              sc[i] = *(const float4*)(MOD + (g * 9 + s_shift + 1) * 1024 + col);
            }
          }
        }
#pragma unroll
        for (int i = 0; i < 4; ++i) {
          float y0 = xv[rr][i].x * rstd * gn[i].x * (1.f + sc[i].x) + sh[i].x;
          float y1 = xv[rr][i].y * rstd * gn[i].y * (1.f + sc[i].y) + sh[i].y;
          float y2 = xv[rr][i].z * rstd * gn[i].z * (1.f + sc[i].z) + sh[i].z;
          float y3 = xv[rr][i].w * rstd * gn[i].w * (1.f + sc[i].w) + sh[i].w;
          u32x2 o; o.x = pack2(y0, y1); o.y = pack2(y2, y3);
          *(u32x2*)(XN + (size_t)t * 1024 + i * 256 + lane * 4) = o;
        }
      }
    }
  }
}

constexpr int BM = 256, BK = 64, HALF = 128, HT = HALF * BK;

DI int lds_byte(int r, int c) {
  int st = (r >> 4) * 2 + (c >> 5), rr = r & 15, cc = c & 31, ob = rr * 64 + cc * 2;
  return st * 1024 + (ob ^ (((ob >> 9) & 1) << 5));
}
DI void stage_rc(int b, int& R, int& C) {
  int st = b / 1024, sb = b % 1024, swz = sb ^ (((sb >> 9) & 1) << 5);
  R = (st >> 1) * 16 + swz / 64; C = (st & 1) * 32 + (swz % 64) / 2;
}

template <int MT, class Epi>
DI void gemm_phase(const u16* __restrict__ A, const u16* __restrict__ Bt, const int K, const int nM, const int nN, Epi epi, int wv) {
  u16* shm = (u16*)dsm;
#define SA(b, h) (shm + ((b) * 2 + (h)) * HT)
#define SB(b, h) (shm + (4 + (b) * 2 + (h)) * HT)
#define STAGE(Pp, BASE, br, kt) do { const char* _gb = (const char*)(BASE) + ((size_t)(br) * K + (size_t)(kt) * BK) * 2; \
    __builtin_amdgcn_global_load_lds((const unsigned*)(_gb + voff0), (unsigned*)((char*)(Pp) + tidl * 16), 16, 0, 0); \
    __builtin_amdgcn_global_load_lds((const unsigned*)(_gb + voff1), (unsigned*)((char*)(Pp) + tidl * 16 + 8192), 16, 0, 0); } while (0)
#define LDA(dst, b, h) for (int m = 0; m < MT; ++m) for (int k = 0; k < 2; ++k) \
    dst[m][k] = *reinterpret_cast<const bf16x8*>((char*)SA(b, h) + lds_byte(wr * (MT * 16) + m * 16 + fr, k * 32 + fq * 8))
#define LDB(dst, b, h) for (int n = 0; n < 2; ++n) for (int k = 0; k < 2; ++k) \
    dst[n][k] = *reinterpret_cast<const bf16x8*>((char*)SB(b, h) + lds_byte(wc * 32 + n * 16 + fr, k * 32 + fq * 8))
#define MMA(ai, bj, At_, Bt_) do { __builtin_amdgcn_s_setprio(1); \
    for (int m = 0; m < MT; ++m) for (int n = 0; n < 2; ++n) for (int k = 0; k < 2; ++k) \
      acc[ai][bj][m][n] = __builtin_amdgcn_mfma_f32_16x16x32_bf16(Bt_[n][k], At_[m][k], acc[ai][bj][m][n], 0, 0, 0); \
    __builtin_amdgcn_s_setprio(0); } while (0)
#define WAIT_V(n) asm volatile("s_waitcnt vmcnt(" #n ")" ::: "memory")
#define WAIT_L(n) asm volatile("s_waitcnt lgkmcnt(" #n ")" ::: "memory")
#define WAIT_LA do { if (MT == 4) asm volatile("s_waitcnt lgkmcnt(8)" ::: "memory"); else asm volatile("s_waitcnt lgkmcnt(6)" ::: "memory"); } while (0)
#define BAR __builtin_amdgcn_s_barrier()
#define SCHED __builtin_amdgcn_sched_barrier(0)

  const int ntiles = nM * nN, per = ntiles / 8;
  const int nt = K / BK;
  int tix = blockIdx.x;
  if (tix < ntiles) {
    const int tidl = ltid(wv);
    const int wid = tidl >> 6, lane = tidl & 63, wr = wid >> 2, wc = wid & 3, fr = lane & 15, fq = lane >> 4;
    unsigned voff0, voff1;
    { int _r, _c; stage_rc(tidl * 16, _r, _c); voff0 = (unsigned)(_r * K + _c) * 2u;
      stage_rc(tidl * 16 + 8192, _r, _c); voff1 = (unsigned)(_r * K + _c) * 2u; }
    const int wgm = nM >> 3, nig = wgm * nN;
    int pm, pn;
    { int lid = (tix & 7) * per + (tix >> 3); int grp = lid / nig, within = lid - grp * nig; pm = grp * wgm + within % wgm; pn = within / wgm; }
    int brow = pm * (MT * 64), bcol = pn * BM;
    bf16x8 At[MT][2], B0[2][2], B1[2][2];
    STAGE(SB(0, 0), Bt, bcol, 0); STAGE(SA(0, 0), A, brow, 0);
    STAGE(SB(0, 1), Bt, bcol + HALF, 0); STAGE(SA(0, 1), A, brow + MT * 32, 0);
    if (wr == 1) BAR;
    WAIT_V(4); BAR;
    STAGE(SB(1, 0), Bt, bcol, 1); STAGE(SA(1, 0), A, brow, 1); STAGE(SB(1, 1), Bt, bcol + HALF, 1);
    WAIT_V(6); BAR;
    while (true) {
      const int ntix = tix + gridDim.x;
      const bool has_next = ntix < ntiles;
      int npm, npn;
      { int lid = ((has_next ? ntix : tix) & 7) * per + ((has_next ? ntix : tix) >> 3); int grp = lid / nig, within = lid - grp * nig; npm = grp * wgm + within % wgm; npn = within / wgm; }
      const int nbrow = npm * (MT * 64), nbcol = npn * BM;
      f32x4 acc[2][2][MT][2] = {};
      for (int t = 0; t < nt; t += 2) {
        const bool last = t + 2 >= nt;
        const int rA = last ? nbrow : brow, rB = last ? nbcol : bcol, k2 = last ? 0 : t + 2, k3 = last ? 1 : t + 3;
        LDB(B0, 0, 0); SCHED; LDA(At, 0, 0); STAGE(SA(1, 1), A, brow + MT * 32, t + 1);
        WAIT_LA; BAR; WAIT_L(0); MMA(0, 0, At, B0); BAR; SCHED;
        LDB(B1, 0, 1); STAGE(SB(0, 0), Bt, rB, k2);
        BAR; WAIT_L(0); MMA(0, 1, At, B1); BAR;
        LDA(At, 0, 1); STAGE(SA(0, 0), A, rA, k2);
        BAR; WAIT_L(0); MMA(1, 0, At, B0); BAR; SCHED;
        STAGE(SB(0, 1), Bt, rB + HALF, k2);
        WAIT_V(6); BAR; MMA(1, 1, At, B1); BAR;
        LDB(B0, 1, 0); SCHED; LDA(At, 1, 0); STAGE(SA(0, 1), A, rA + MT * 32, k2);
        WAIT_LA; BAR; WAIT_L(0); MMA(0, 0, At, B0); BAR; SCHED;
        LDB(B1, 1, 1); STAGE(SB(1, 0), Bt, rB, k3);
        BAR; WAIT_L(0); MMA(0, 1, At, B1); BAR;
        LDA(At, 1, 1); STAGE(SA(1, 0), A, rA, k3);
        BAR; WAIT_L(0); MMA(1, 0, At, B0); BAR; SCHED;
        STAGE(SB(1, 1), Bt, rB + HALF, k3);
        WAIT_V(6); BAR; MMA(1, 1, At, B1); BAR;
      }
      {
        int t2 = ltid(wv);
        const int wid2 = t2 >> 6, lane2 = t2 & 63;
        epi(pm, pn, acc, wid2 >> 2, wid2 & 3, lane2 & 15, lane2 >> 4);
      }
      WAIT_V(0);
      if (!has_next) break;
      tix = ntix; pm = npm; pn = npn; brow = nbrow; bcol = nbcol;
    }
    if (wr == 0) BAR;
    __syncthreads();
  }
#undef WAIT_LA
#undef SA
#undef SB
#undef STAGE
#undef LDA
#undef LDB
#undef MMA
}

struct EpiSwiGLU {
  u16* HID;
  DI void operator()(int pm, int pn, f32x4 (&acc)[2][2][4][2], int wr, int wc, int fr, int fq) const {
#pragma unroll
    for (int ai = 0; ai < 2; ++ai)
#pragma unroll
      for (int m = 0; m < 4; ++m) {
        int t = pm * 256 + ai * 128 + wr * 64 + m * 16 + fr;
        {
          const int hc = pn * 128 + wc * 32 + fq * 8;
          f32x4 g0 = acc[ai][0][m][0], u0 = acc[ai][1][m][0], g1 = acc[ai][0][m][1], u1 = acc[ai][1][m][1];
          u32x4 o;
          o.x = pack2(siluf(g0[0]) * u0[0], siluf(g0[1]) * u0[1]);
          o.y = pack2(siluf(g0[2]) * u0[2], siluf(g0[3]) * u0[3]);
          o.z = pack2(siluf(g1[0]) * u1[0], siluf(g1[1]) * u1[1]);
          o.w = pack2(siluf(g1[2]) * u1[2], siluf(g1[3]) * u1[3]);
          *(u32x4*)(HID + (size_t)t * DFF + hc) = o;
        }
      }
  }
};

struct EpiResid {
  const float* xp; const float* xs;
  float* out; const float* MOD; int slot; float coef;
  DI void operator()(int pm, int pn, f32x4 (&acc)[2][2][4][2], int wr, int wc, int fr, int fq) const {
    const int g = pm < 32 ? 0 : 1 + ((pm - 32) >> 2);
    const float* gate = MOD + (g * 9 + slot) * 1024 + pn * 256;
    const float* xin = pm < 32 ? xp + (size_t)pm * 262144 + pn * 256 : xs + (size_t)(pm - 32) * 262144 + pn * 256;
    float* o = out + (size_t)pm * 262144 + pn * 256;
    const unsigned cbase = wc * 32 + fq * 4, rbase = wr * 64 + fr;
#pragma unroll
    for (int bj = 0; bj < 2; ++bj)
#pragma unroll
      for (int n = 0; n < 2; ++n) {
        const unsigned col = cbase + bj * 128 + n * 16;
        const float4 gt = *(const float4*)(gate + col);
#pragma unroll
        for (int aim = 0; aim < 4; ++aim) {
          const int ai = aim >> 1;
          asm volatile("" ::: "memory");
          float4 xi[2][4];
#pragma unroll
          for (int m = (aim & 1) * 2; m < (aim & 1) * 2 + 2; ++m) xi[ai][m] = *(const float4*)(xin + (rbase + ai * 128 + m * 16) * 1024u + col);
#pragma unroll
          for (int m = (aim & 1) * 2; m < (aim & 1) * 2 + 2; ++m) {
            const unsigned off = (rbase + ai * 128 + m * 16) * 1024u + col;
            f32x4 a = acc[ai][bj][m][n];
            float4 r;
            r.x = xi[ai][m].x + coef * gt.x * a[0]; r.y = xi[ai][m].y + coef * gt.y * a[1];
            r.z = xi[ai][m].z + coef * gt.z * a[2]; r.w = xi[ai][m].w + coef * gt.w * a[3];
            *(float4*)(o + off) = r;
          }
        }
      }
  }
};

struct EpiResid192 {
  const float* xp; const float* xs; float* out; const float* MOD; int slot; float coef;
  DI void operator()(int pm, int pn, f32x4 (&acc)[2][2][3][2], int wr, int wc, int fr, int fq) const {
    const unsigned cbase = pn * 256 + wc * 32 + fq * 4;
#pragma unroll
    for (int bj = 0; bj < 2; ++bj) {
      asm volatile("" ::: "memory");
      float4 xi[2][3][2];
#pragma unroll
      for (int ai = 0; ai < 2; ++ai)
#pragma unroll
        for (int m = 0; m < 3; ++m) {
          const int t = pm * 192 + ai * 96 + wr * 48 + m * 16 + fr;
          const float* xin = t < T_P ? xp + (size_t)t * 1024 : xs + (size_t)(t - T_P) * 1024;
#pragma unroll
          for (int n = 0; n < 2; ++n) xi[ai][m][n] = *(const float4*)(xin + cbase + bj * 128 + n * 16);
        }
#pragma unroll
      for (int ai = 0; ai < 2; ++ai)
#pragma unroll
        for (int m = 0; m < 3; ++m) {
          const int t = pm * 192 + ai * 96 + wr * 48 + m * 16 + fr;
          const float* gate = MOD + (tok_group(t) * 9 + slot) * 1024;
          float* o = out + (size_t)t * 1024;
#pragma unroll
          for (int n = 0; n < 2; ++n) {
            const float4 gt = *(const float4*)(gate + cbase + bj * 128 + n * 16);
            f32x4 a = acc[ai][bj][m][n];
            float4 r;
            r.x = xi[ai][m][n].x + coef * gt.x * a[0]; r.y = xi[ai][m][n].y + coef * gt.y * a[1];
            r.z = xi[ai][m][n].z + coef * gt.z * a[2]; r.w = xi[ai][m][n].w + coef * gt.w * a[3];
            *(float4*)(o + cbase + bj * 128 + n * 16) = r;
          }
        }
    }
  }
};

struct EpiInProj {
  char* ws; float* out;
  DI void operator()(int pm, int pn, f32x4 (&acc)[2][2][4][2], int wr, int wc, int fr, int fq) const {
    const bool sample = pm >= 32;
    const unsigned rbase = wr * 64 + fr;
    const unsigned cb0 = wc * 32 + fq * 4;
    if (pn < 8) {
      u16* ZA = (u16*)(ws + OFF_ZA) + (size_t)pm * 256 * 2048 + pn * 256;
#pragma unroll
      for (int ai = 0; ai < 2; ++ai)
#pragma unroll
        for (int m = 0; m < 4; ++m)
#pragma unroll
          for (int bj = 0; bj < 2; ++bj) {
            f32x4 a = acc[ai][bj][m][0], b = acc[ai][bj][m][1];
            u32x4 o; o.x = pack2(a[0], a[1]); o.y = pack2(a[2], a[3]); o.z = pack2(b[0], b[1]); o.w = pack2(b[2], b[3]);
            *(u32x4*)(ZA + (rbase + ai * 128 + m * 16) * 2048u + wc * 32 + fq * 8 + bj * 128) = o;
          }
    } else if (pn < 12) {
      const bool isq = pn < 10;
      const float* rope = (const float*)(ws + OFF_ROPE);
      const unsigned cq = (pn & 1) * 256 + cb0;
      u16* dstb;
      unsigned rstride = 512;
      if (isq) dstb = (u16*)(ws + OFF_Q) + (size_t)pm * 256 * 512;
      else if (!sample) dstb = (u16*)(ws + OFF_KP) + (size_t)pm * 256 * 512;
      else dstb = (u16*)(ws + OFF_KS) + ((size_t)((pm - 32) >> 2) * 1280 + 256 + ((pm - 32) & 3) * 256) * 512;
      float* ko = out + OUT_K + (size_t)pm * 256 * 512;
      const int slb = ((pm - 32) & 3) * 256;
#pragma unroll
      for (int ai = 0; ai < 2; ++ai) {
        asm volatile("" ::: "memory");
        float4 csv[4], snv[4];
#pragma unroll
        for (int m = 0; m < 4; ++m) {
          csv[m] = make_float4(1.f, 1.f, 1.f, 1.f); snv[m] = make_float4(0.f, 0.f, 0.f, 0.f);
          if (sample) {
            int sl = slb + rbase + ai * 128 + m * 16;
            int pos = (wc & 1) ? (sl & 63) : (sl >> 6);
            csv[m] = *(const float4*)(rope + pos * 16 + fq * 4);
            snv[m] = *(const float4*)(rope + 1024 + pos * 16 + fq * 4);
          }
        }
#pragma unroll
        for (int m = 0; m < 4; ++m) {
          const unsigned row = rbase + ai * 128 + m * 16;
          const float4 cs = csv[m], sn = snv[m];
#pragma unroll
          for (int bj = 0; bj < 2; ++bj) {
            f32x4 v1 = acc[ai][bj][m][0], v2 = acc[ai][bj][m][1];
            const unsigned off = row * rstride + cq + bj * 128;
            if (!sample && !isq) {
              nt_store4(make_float4(v1[0], v1[1], v1[2], v1[3]), ko + off);
              nt_store4(make_float4(v2[0], v2[1], v2[2], v2[3]), ko + off + 16);
            }
            f32x4 o1, o2;
            o1[0] = v1[0] * cs.x - v2[0] * sn.x; o2[0] = v2[0] * cs.x + v1[0] * sn.x;
            o1[1] = v1[1] * cs.y - v2[1] * sn.y; o2[1] = v2[1] * cs.y + v1[1] * sn.y;
            o1[2] = v1[2] * cs.z - v2[2] * sn.z; o2[2] = v2[2] * cs.z + v1[2] * sn.z;
            o1[3] = v1[3] * cs.w - v2[3] * sn.w; o2[3] = v2[3] * cs.w + v1[3] * sn.w;
            if (isq) { o1 *= 0.18033688011112042f; o2 *= 0.18033688011112042f; }
            u32x2 o1p, o2p;
            o1p.x = pack2(o1[0], o1[1]); o1p.y = pack2(o1[2], o1[3]);
            o2p.x = pack2(o2[0], o2[1]); o2p.y = pack2(o2[2], o2[3]);
            {
              u32x4 oq; oq.x = o1p.x; oq.y = o1p.y; oq.z = o2p.x; oq.w = o2p.y;
              *(u32x4*)(dstb + row * rstride + (pn & 1) * 256 + bj * 128 + wc * 32 + fq * 8) = oq;
            }
          }
        }
      }
    } else if (pn < 14) {
      const unsigned cv0 = (pn & 1) * 256 + wc * 32 + fq * 8;
      float* vo = out + OUT_V + (size_t)pm * 256 * 512;
      u16* vb = sample ? (u16*)(ws + OFF_VTS) + ((size_t)((pm - 32) >> 2) * 1280 + 256 + ((pm - 32) & 3) * 256) * 512
                       : (u16*)(ws + OFF_VTP) + (size_t)pm * 256 * 512;
#pragma unroll
      for (int ai = 0; ai < 2; ++ai)
#pragma unroll
        for (int m = 0; m < 4; ++m)
#pragma unroll
          for (int bj = 0; bj < 2; ++bj) {
            f32x4 a = acc[ai][bj][m][0], b = acc[ai][bj][m][1];
            const unsigned off = (rbase + ai * 128 + m * 16) * 512u + cv0 + bj * 128;
            if (!sample) {
              nt_store4(make_float4(a[0], a[1], a[2], a[3]), vo + off);
              nt_store4(make_float4(b[0], b[1], b[2], b[3]), vo + off + 4);
            }
            u32x4 o; o.x = pack2(a[0], a[1]); o.y = pack2(a[2], a[3]); o.z = pack2(b[0], b[1]); o.w = pack2(b[2], b[3]);
            *(u32x4*)(vb + off) = o;
          }
    } else {
      if (wc == 0) {
        float* GB = (float*)(ws + OFF_GB) + (size_t)pm * 256 * 32;
#pragma unroll
        for (int ai = 0; ai < 2; ++ai)
#pragma unroll
          for (int m = 0; m < 4; ++m)
#pragma unroll
            for (int n = 0; n < 2; ++n) {
              f32x4 a = acc[ai][0][m][n];
              *(float4*)(GB + (rbase + ai * 128 + m * 16) * 32u + n * 16 + fq * 4) = make_float4(a[0], a[1], a[2], a[3]);
            }
      }
    }
  }
};

constexpr int LQS = 0, LKB = 9216, LVB = 18432, LA = 27648, LQK = 44032, LKG = 53248, LST = 62464, LSM = 71680, HSZ = 73216, LW2 = 81920, LU2 = 91136;

DI f32x4 mma16(bf16x8 a, bf16x8 b, f32x4 c) { return __builtin_amdgcn_mfma_f32_16x16x32_bf16(a, b, c, 0, 0, 0); }
DI f32x4 mma_nt64(const char* Aop, const char* Bop, int i0, int j0, int fr, int fq, f32x4 acc) {
#pragma unroll
  for (int ks = 0; ks < 2; ++ks) {
    bf16x8 a = *(const bf16x8*)(Aop + (i0 + fr) * 144 + (ks * 32 + fq * 8) * 2);
    bf16x8 b = *(const bf16x8*)(Bop + (j0 + fr) * 144 + (ks * 32 + fq * 8) * 2);
    acc = mma16(a, b, acc);
  }
  return acc;
}

constexpr int LCW = HSZ;
DI void conv_decode(int item, int& m, int& h, int& L, int& base) {
  if (item < 1024) { const int seq = item >> 5; m = (item >> 3) & 3; h = item & 7; L = 256; base = seq * 256; }
  else { const int i2 = item - 1024; m = (i2 >> 3) & 15; h = i2 & 7; L = 1024; base = T_P + (i2 >> 7) * 1024; }
}
DI void conv_load(const P& p, const u16* ZA, int item, int tid, u32x4 (&zr)[4], float (&cwv)[2]) {
  int m, h, L, base; conv_decode(item, m, h, L, base);
#pragma unroll
  for (int i = 0; i < 4; ++i) {
    int id = tid + 512 * i;
    int row = id / 24, rem = id - row * 24;
    int s = m * 64 - 2 + row;
    u32x4 v = {0u, 0u, 0u, 0u};
    if (id < 1632 && s >= 0 && s < L) v = *(const u32x4*)(ZA + (size_t)(base + s) * 2048 + (rem >> 3) * 512 + h * 64 + (rem & 7) * 8);
    zr[i] = v;
  }
#pragma unroll
  for (int i = 0; i < 2; ++i) {
    int e = tid + 512 * i; cwv[i] = 0.f;
    if (e < 960) { int part = e / 320, r2 = e - part * 320, j = r2 >> 6, d = r2 & 63; cwv[i] = p.conv_w[j * 1536 + part * 512 + h * 64 + d]; }
  }
}
DI void conv_phase(CP pp, int wv) {
  const P p = ldp(pp);
  const u16* ZA = (const u16*)(p.ws + OFF_ZA);
  u16* QK = (u16*)(p.ws + OFF_XN);
  u16* VV = (u16*)(p.ws + OFF_WB1);
  u32x4 zr[4]; float cwv[2];
  if ((int)blockIdx.x < 1536) conv_load(p, ZA, blockIdx.x, ltid(wv), zr, cwv);
  for (int item = blockIdx.x; item < 1536; item += gridDim.x) {
    int m, h, L, base; conv_decode(item, m, h, L, base);
    const int tid = ltid(wv), lw = tid >> 6, lane = tid & 63;
    __syncthreads();
#pragma unroll
    for (int i = 0; i < 4; ++i) { int id = tid + 512 * i; if (id < 1632) *(u32x4*)(dsm + id * 16) = zr[i]; }
#pragma unroll
    for (int i = 0; i < 2; ++i) { int e = tid + 512 * i; if (e < 960) ((float*)(dsm + 26624))[e] = cwv[i]; }
    __syncthreads();
    if (item + (int)gridDim.x < 1536) conv_load(p, ZA, item + gridDim.x, tid, zr, cwv);
    {
      const int d = lane, so = lw * 8;
      const float* cwl = (const float*)(dsm + 26624);
#pragma unroll
      for (int part = 0; part < 3; ++part) {
        float cw[5];
#pragma unroll
        for (int j = 0; j < 5; ++j) cw[j] = cwl[part * 320 + j * 64 + d];
        float zv[12];
#pragma unroll
        for (int i = 0; i < 12; ++i) zv[i] = bf2f(*(const u16*)(dsm + (so + i) * 384 + part * 128 + d * 2));
#pragma unroll
        for (int i = 0; i < 8; ++i) {
          float v = cw[0] * zv[i] + cw[1] * zv[i + 1] + cw[2] * zv[i + 2] + cw[3] * zv[i + 3] + cw[4] * zv[i + 4];
          v = siluf(v);
          if (part < 2) {
            float ss = wave_sum(v * v);
            v *= rsqrtf(ss + 1e-6f);
            if (part == 0) v *= 0.125f;
          }
          const size_t t = (size_t)(base + m * 64 + so + i);
          if (part < 2) QK[((t * 8 + h) * 2 + part) * 64 + d] = f2bf(v);
          else VV[(t * 8 + h) * 64 + d] = f2bf(v);
        }
      }
    }
  }
  __syncthreads();
}
DI void dn_prefetch(const u16* QK, const u16* VV, const float* GB, int base, int mch, int hf, int h, int tid, u32x4 (&zr)[3], float& gad, float& gab) {
  const int r = (tid & 511) >> 3, cp = tid & 7;
  const size_t t = (size_t)(base + mch * 64 + r);
  zr[0] = *(const u32x4*)(QK + ((t * 8 + h) * 2 + 0) * 64 + cp * 8);
  zr[1] = *(const u32x4*)(QK + ((t * 8 + h) * 2 + 1) * 64 + cp * 8);
  zr[2] = *(const u32x4*)(VV + (t * 8 + h) * 64 + cp * 8);
  if (tid < 64) {
    int tk = base + mch * 64 + (hf ? 63 - tid : tid);
    gad = GB[(size_t)tk * 32 + hf * 8 + h];
    gab = GB[(size_t)tk * 32 + 16 + hf * 8 + h];
  }
}

DI void deltanet_item(const P& p, int item, int wv) {
  const int seq = item >> 4, h = (item >> 1) & 7, hf = item & 1;
  const bool sample = seq >= 32;
  const int L = sample ? 1024 : 256, N = L >> 6;
  const int base = sample ? T_P + (seq - 32) * 1024 : seq * 256;
  const u16* QK = (const u16*)(p.ws + OFF_XN);
  const u16* VV = (const u16*)(p.ws + OFF_WB1);
  const float* GB = (const float*)(p.ws + OFF_GB);
  char* hb = dsm;
  float* sm = (float*)(hb + LSM);
  u16* OB = (u16*)(p.ws + OFF_HID) + (size_t)hf * T_TOK * 512;
  const float alog = -expf(p.a_log[hf * 8 + h]);
  const float dtb = p.dt_bias[hf * 8 + h];

  f32x4 sacc[2];
  u32x4 zr[3]; float gad = 0.f, gab = 0.f;
  {
    const int tid = ltid(wv), lw = tid >> 6, lane = tid & 63, fr = lane & 15, fq = lane >> 4;
#pragma unroll
    for (int k = 0; k < 2; ++k) {
      const int dt = 2 * (lw >> 2) + k, et = lw & 3;
      if (sample) {
        const float* s0 = p.state + (((size_t)(seq - 32) * 2 + hf) * 8 + h) * 4096;
#pragma unroll
        for (int r = 0; r < 4; ++r) sacc[k][r] = s0[(dt * 16 + fq * 4 + r) * 64 + et * 16 + fr];
      } else {
        sacc[k] = f32x4{0.f, 0.f, 0.f, 0.f};
      }
      u32x2 o; o.x = pack2(sacc[k][0], sacc[k][1]); o.y = pack2(sacc[k][2], sacc[k][3]);
      *(u32x2*)(hb + LST + (et * 16 + fr) * 144 + (dt * 16 + fq * 4) * 2) = o;
    }
    dn_prefetch(QK, VV, GB, base, hf ? N - 1 : 0, hf, h, tid, zr, gad, gab);
  }

  for (int n = 0; n < N; ++n) {
    const int tid = ltid(wv);
    const int lw = tid >> 6, lane = tid & 63, fr = lane & 15, fq = lane >> 4;
    const int wq = lw & 3, wh = lw >> 2;
    const int mch = hf ? N - 1 - n : n;
    {
      const int r = tid >> 3, cp = tid & 7, c = hf ? 63 - r : r;
      *(u32x4*)(hb + LQS + c * 144 + cp * 16) = zr[0];
      *(u32x4*)(hb + LKB + c * 144 + cp * 16) = zr[1];
      *(u32x4*)(hb + LVB + c * 144 + cp * 16) = zr[2];
    }
    if (lw == 0) {
      const int c = lane;
      const float ad = gad + dtb;
      float sp = ad > 20.f ? ad : log1pf(expf(ad));
      float g = alog * sp;
      float bt = 1.f / (1.f + expf(-gab));
      float gc = g;
#pragma unroll
      for (int o = 1; o < 64; o <<= 1) { float v = __shfl_up(gc, o); if (lane >= o) gc += v; }
      float gl = __shfl(gc, 63);
      const float egc_ = expf(gc);
      sm[c] = gc; sm[64 + c] = bt; sm[128 + c] = egc_; sm[192 + c] = expf(gl - gc); sm[256 + c] = bt; sm[320 + c] = bt * egc_;
    }
    __syncthreads();
    {
#pragma unroll
      for (int k = 0; k < 2; ++k) {
        const int jt = 2 * wh + k;
        f32x4 dk = mma_nt64(hb + LKB, hb + LKB, wq * 16, jt * 16, fr, fq, f32x4{0.f, 0.f, 0.f, 0.f});
        int s = jt * 16 + fr;
        float gs = sm[s];
#pragma unroll
        for (int r = 0; r < 4; ++r) {
          int c = wq * 16 + fq * 4 + r;
          float v = s < c ? sm[64 + c] * dk[r] * __expf(sm[c] - gs) : 0.f;
          *(float*)(hb + LA + (s * 64 + (c & 3) * 16 + (c >> 2)) * 4) = v;
        }
      }
#pragma unroll
      for (int k = 0; k < 2; ++k) {
        const int it = 2 * wh + k;
        f32x4 dq = mma_nt64(hb + LKB, hb + LQS, it * 16, wq * 16, fr, fq, f32x4{0.f, 0.f, 0.f, 0.f});
        int c = wq * 16 + fr;
        float gcc = sm[c];
        float v[4];
#pragma unroll
        for (int r = 0; r < 4; ++r) {
          int s = it * 16 + fq * 4 + r;
          v[r] = s <= c ? dq[r] * __expf(gcc - sm[s]) : 0.f;
        }
        u32x2 o; o.x = pack2(v[0], v[1]); o.y = pack2(v[2], v[3]);
        *(u32x2*)(hb + LQK + c * 144 + (it * 16 + fq * 4) * 2) = o;
      }
    }
    __syncthreads();
    if (n + 1 < N) dn_prefetch(QK, VV, GB, base, hf ? N - 2 - n : n + 1, hf, h, tid, zr, gad, gab);
    {
      const int d = lane;
#pragma unroll
      for (int i = 0; i < 8; i += 2) {
        int c = lw * 8 + i;
        float k0 = bf2f(*(const u16*)(hb + LKB + c * 144 + d * 2)) * sm[192 + c];
        float k1 = bf2f(*(const u16*)(hb + LKB + (c + 1) * 144 + d * 2)) * sm[192 + c + 1];
        *(unsigned*)(hb + LKG + d * 144 + c * 2) = pack2(k0, k1);
      }
    }
    float xp[16];
    const int sj = tid >> 2, par = tid & 3;
    {
      const float* ATb = (const float*)(hb + LA) + par * 16;
      const char* rsrc = (sj < 64) ? hb + LVB + sj * 2 : hb + LKB + (sj - 64) * 2;
      const float* rs = sm + (sj < 64 ? 256 : 320);
#pragma unroll
      for (int i = 0; i < 16; ++i) xp[i] = rs[4 * i + par] * bf2f(*(const u16*)(rsrc + (4 * i + par) * 144));
#define DN_LOADA(dst, s_) _Pragma("unroll") for (int q = (((s_) >> 2) >> 2); q < 4; ++q) dst[q] = *(const float4*)(ATb + (s_) * 64 + q * 4)
#define DN_STEP(s_, Aq) do { const float xs_ = quad_bcast(xp[(s_) >> 2], (s_)); const f32x2 xs2_ = {xs_, xs_}; \
        _Pragma("unroll") for (int q = (((s_) >> 2) >> 2); q < 4; ++q) { \
          f32x2 lo_ = {xp[4 * q], xp[4 * q + 1]}, hi_ = {xp[4 * q + 2], xp[4 * q + 3]}; \
          const f32x2 al_ = {Aq[q].x, Aq[q].y}, ah_ = {Aq[q].z, Aq[q].w}; \
          lo_ = __builtin_elementwise_fma(-al_, xs2_, lo_); hi_ = __builtin_elementwise_fma(-ah_, xs2_, hi_); \
          xp[4 * q] = lo_[0]; xp[4 * q + 1] = lo_[1]; xp[4 * q + 2] = hi_[0]; xp[4 * q + 3] = hi_[1]; } } while (0)
      float4 A0[4], A1[4], A2[4], A3[4];
      DN_LOADA(A0, 0); DN_LOADA(A1, 1);
#pragma unroll
      for (int s = 0; s < 60; s += 4) {
        DN_LOADA(A2, s + 2); DN_LOADA(A3, s + 3); __builtin_amdgcn_sched_barrier(0);
        DN_STEP(s, A0); DN_STEP(s + 1, A1); __builtin_amdgcn_sched_barrier(0);
        DN_LOADA(A0, s + 4); DN_LOADA(A1, s + 5); __builtin_amdgcn_sched_barrier(0);
        DN_STEP(s + 2, A2); DN_STEP(s + 3, A3); __builtin_amdgcn_sched_barrier(0);
      }
      DN_LOADA(A2, 62); __builtin_amdgcn_sched_barrier(0);
      DN_STEP(60, A0); DN_STEP(61, A1); DN_STEP(62, A2);
    }
    if (sj < 64) {
#pragma unroll
      for (int i = 0; i < 16; ++i) *(u16*)(hb + LU2 + sj * 144 + (4 * i + par) * 2) = f2bf(xp[i]);
    } else {
#pragma unroll
      for (int i = 0; i < 16; ++i) *(u16*)(hb + LW2 + (4 * i + par) * 144 + (sj - 64) * 2) = f2bf(xp[i]);
    }
    __syncthreads();
    {
#pragma unroll
      for (int k = 0; k < 2; ++k) {
        const int ct = 2 * wh + k;
        f32x4 dd = mma_nt64(hb + LW2, hb + LST, ct * 16, wq * 16, fr, fq, f32x4{0.f, 0.f, 0.f, 0.f});
        int e = wq * 16 + fr;
        u32x2 u0 = *(const u32x2*)(hb + LU2 + e * 144 + (ct * 16 + fq * 4) * 2);
        float v0 = __uint_as_float(u0.x << 16) - dd[0], v1 = __uint_as_float(u0.x & 0xffff0000u) - dd[1];
        float v2 = __uint_as_float(u0.y << 16) - dd[2], v3 = __uint_as_float(u0.y & 0xffff0000u) - dd[3];
        u32x2 o; o.x = pack2(v0, v1); o.y = pack2(v2, v3);
        *(u32x2*)(hb + LA + e * 144 + (ct * 16 + fq * 4) * 2) = o;
      }
    }
    __syncthreads();
    {
      const int c = wq * 16 + fr;
      const float egc = sm[128 + c];
      const int tk = base + mch * 64 + (hf ? 63 - c : c);
#pragma unroll
      for (int k = 0; k < 2; ++k) {
        const int et = 2 * wh + k;
        f32x4 o = mma_nt64(hb + LST, hb + LQS, et * 16, wq * 16, fr, fq, f32x4{0.f, 0.f, 0.f, 0.f});
        o *= egc;
        o = mma_nt64(hb + LA, hb + LQK, et * 16, wq * 16, fr, fq, o);
        { u32x2 ov; ov.x = pack2(o[0], o[1]); ov.y = pack2(o[2], o[3]); *(u32x2*)(OB + (size_t)tk * 512 + h * 64 + et * 16 + fq * 4) = ov; }
      }
      const float egl = sm[128 + 63];
#pragma unroll
      for (int k = 0; k < 2; ++k) {
        const int dt = 2 * wh + k;
        sacc[k] *= egl;
        sacc[k] = mma_nt64(hb + LKG, hb + LA, dt * 16, wq * 16, fr, fq, sacc[k]);
      }
    }
    __syncthreads();
#pragma unroll
    for (int k = 0; k < 2; ++k) {
      const int dt = 2 * wh + k;
      u32x2 o; o.x = pack2(sacc[k][0], sacc[k][1]); o.y = pack2(sacc[k][2], sacc[k][3]);
      *(u32x2*)(hb + LST + (wq * 16 + fr) * 144 + (dt * 16 + fq * 4) * 2) = o;
    }
  }
  if (!sample) {
    const int tid = ltid(wv), lw = tid >> 6, lane = tid & 63, fr = lane & 15, fq = lane >> 4;
    float* so = p.out + OUT_S + (((size_t)seq * 2 + hf) * 8 + h) * 4096;
#pragma unroll
    for (int k = 0; k < 2; ++k)
#pragma unroll
      for (int r = 0; r < 4; ++r) so[((2 * (lw >> 2) + k) * 16 + fq * 4 + r) * 64 + (lw & 3) * 16 + fr] = sacc[k][r];
  }
  __syncthreads();
}

DI f32x16 mma32(bf16x8 a, bf16x8 b, f32x16 c) { return __builtin_amdgcn_mfma_f32_32x32x16_bf16(a, b, c, 0, 0, 0); }

DI void attn_item(const P& p, int item, int wv) {
  const int tid = ltid(wv), wid = tid >> 6, lane = tid & 63, r = lane & 31, h = lane >> 5;
  int b, head, qb, nk, tokbase;
  const u16* Kg; const u16* Vg;
  if (item < 64) {
    b = item >> 4; head = (item >> 2) & 3; qb = item & 3; nk = 1280; tokbase = T_P + b * 1024 + qb * 256;
    Kg = (const u16*)(p.ws + OFF_KS) + (size_t)b * 1280 * 512 + head * 128;
    Vg = (const u16*)(p.ws + OFF_VTS) + (size_t)b * 1280 * 512 + head * 128;
  } else {
    int id = item - 64; b = id >> 2; head = id & 3; qb = 0; nk = 256; tokbase = b * 256;
    Kg = (const u16*)(p.ws + OFF_KP) + (size_t)b * 256 * 512 + head * 128;
    Vg = (const u16*)(p.ws + OFF_VTP) + (size_t)b * 256 * 512 + head * 128;
  }
  float s1 = wave_sum(p.lq1[lane] * p.lk1[lane]);
  float s2 = wave_sum(p.lq2[lane] * p.lk2[lane]);
  const float lam = expf(s1) - expf(s2) + 0.2f;
  const int tq = tokbase + wid * 32 + r;
  const u16* Qg = (const u16*)(p.ws + OFF_Q) + (size_t)tq * 512 + head * 128;
  bf16x8 q[2][4];
#pragma unroll
  for (int mp = 0; mp < 2; ++mp)
#pragma unroll
    for (int ks = 0; ks < 4; ++ks) q[mp][ks] = *(const bf16x8*)(Qg + mp * 64 + ks * 16 + 8 * h);
  const int ntile = nk >> 6;
  float m0 = -1e30f, m1 = -1e30f, l0 = 0.f, l1 = 0.f;
  u32x4 kr[2], vr[2] = {};
  {
#pragma unroll
    for (int i = 0; i < 2; ++i) { int id = tid + 512 * i; int row = id >> 4, cp = id & 15;
      kr[i] = *(const u32x4*)(Kg + (size_t)row * 512 + cp * 8); }
  }
  __syncthreads();
  for (int t = 0; t < ntile; ++t) {
    char* KT = dsm + (t & 1) * 36864;
#pragma unroll
    for (int i = 0; i < 2; ++i) { int id = tid + 512 * i; int row = id >> 4, cp = id & 15;
      *(u32x4*)(KT + row * 272 + cp * 16) = kr[i]; }
    __syncthreads();
    if (t + 1 < ntile) {
#pragma unroll
      for (int i = 0; i < 2; ++i) { int id = tid + 512 * i; int row = id >> 4, cp = id & 15;
        kr[i] = *(const u32x4*)(Kg + (size_t)((t + 1) * 64 + row) * 512 + cp * 8); }
    } else {
#pragma unroll
      for (int i = 0; i < 2; ++i) { int id = tid + 512 * i; int row = id >> 4, cp = id & 15;
        kr[i] = *(const u32x4*)(Kg + (size_t)row * 512 + cp * 8);
        int vkey = id & 63, vcp = id >> 6;
        vr[i] = *(const u32x4*)(Vg + (size_t)vkey * 512 + vcp * 8); }
    }
#pragma unroll
    for (int kb2 = 0; kb2 < 2; ++kb2) {
      f32x16 sa = {}, sb = {};
#pragma unroll
      for (int ks = 0; ks < 4; ++ks) {
        bf16x8 a0 = *(const bf16x8*)(KT + (kb2 * 32 + r) * 272 + (ks * 16 + 8 * h) * 2);
        bf16x8 a1 = *(const bf16x8*)(KT + (kb2 * 32 + r) * 272 + (64 + ks * 16 + 8 * h) * 2);
        sa = mma32(a0, q[0][ks], sa); sb = mma32(a1, q[1][ks], sb);
      }
      float mx0 = sa[0], mx1 = sb[0];
#pragma unroll
      for (int i = 1; i < 16; ++i) { mx0 = fmaxf(mx0, sa[i]); mx1 = fmaxf(mx1, sb[i]); }
      float n0 = fmaxf(m0, mx0), n1 = fmaxf(m1, mx1);
      f32x2 acc0 = {0.f, 0.f}, acc1 = {0.f, 0.f};
      const f32x2 nn0 = {n0, n0}, nn1 = {n1, n1};
#pragma unroll
      for (int i = 0; i < 16; i += 2) {
        f32x2 d0 = f32x2{sa[i], sa[i + 1]} - nn0, d1 = f32x2{sb[i], sb[i + 1]} - nn1;
        acc0 += f32x2{__builtin_amdgcn_exp2f(d0[0]), __builtin_amdgcn_exp2f(d0[1])};
        acc1 += f32x2{__builtin_amdgcn_exp2f(d1[0]), __builtin_amdgcn_exp2f(d1[1])};
      }
      const float a0 = acc0[0] + acc0[1], a1 = acc1[0] + acc1[1];
      l0 = l0 * __builtin_amdgcn_exp2f(m0 - n0) + a0; l1 = l1 * __builtin_amdgcn_exp2f(m1 - n1) + a1;
      m0 = n0; m1 = n1;
    }
  }
  {
    float mo0 = __shfl_xor(m0, 32), lo0 = __shfl_xor(l0, 32), mo1 = __shfl_xor(m1, 32), lo1 = __shfl_xor(l1, 32);
    float M0 = fmaxf(m0, mo0), M1 = fmaxf(m1, mo1);
    l0 = l0 * __builtin_amdgcn_exp2f(m0 - M0) + lo0 * __builtin_amdgcn_exp2f(mo0 - M0);
    l1 = l1 * __builtin_amdgcn_exp2f(m1 - M1) + lo1 * __builtin_amdgcn_exp2f(mo1 - M1);
    m0 = M0; m1 = M1;
  }
  const float f0 = m0 + __log2f(l0);
  const float f1 = m1 + __log2f(l1) - __log2f(fmaxf(fabsf(lam), 1e-30f));
  const float sg = lam < 0.f ? -1.f : 1.f;
  f32x16 oacc[4] = {};
  __syncthreads();
  for (int t = 0; t < ntile; ++t) {
    char* KT = dsm + (t & 1) * 36864;
    char* VT = KT + 17408;
#pragma unroll
    for (int i = 0; i < 2; ++i) { int id = tid + 512 * i; int row = id >> 4, cp = id & 15;
      *(u32x4*)(KT + row * 272 + cp * 16) = kr[i];
      int vkey = id & 63, vcp = id >> 6;
      const unsigned vw[4] = {vr[i].x, vr[i].y, vr[i].z, vr[i].w};
#pragma unroll
      for (int j = 0; j < 4; ++j) {
        *(u16*)(VT + (vcp * 8 + 2 * j) * 144 + vkey * 2) = (u16)(vw[j] & 0xffffu);
        *(u16*)(VT + (vcp * 8 + 2 * j + 1) * 144 + vkey * 2) = (u16)(vw[j] >> 16);
      } }
    __syncthreads();
    if (t + 1 < ntile) {
#pragma unroll
      for (int i = 0; i < 2; ++i) { int id = tid + 512 * i; int row = id >> 4, cp = id & 15;
        kr[i] = *(const u32x4*)(Kg + (size_t)((t + 1) * 64 + row) * 512 + cp * 8);
        int vkey = id & 63, vcp = id >> 6;
        vr[i] = *(const u32x4*)(Vg + (size_t)((t + 1) * 64 + vkey) * 512 + vcp * 8); }
    }
#pragma unroll
    for (int kb2 = 0; kb2 < 2; ++kb2) {
      f32x16 sa = {}, sb = {};
#pragma unroll
      for (int ks = 0; ks < 4; ++ks) {
        bf16x8 a0 = *(const bf16x8*)(KT + (kb2 * 32 + r) * 272 + (ks * 16 + 8 * h) * 2);
        bf16x8 a1 = *(const bf16x8*)(KT + (kb2 * 32 + r) * 272 + (64 + ks * 16 + 8 * h) * 2);
        sa = mma32(a0, q[0][ks], sa); sb = mma32(a1, q[1][ks], sb);
      }
      float av[16];
      {
        const f32x2 ff0 = {f0, f0}, ff1 = {f1, f1}, nsg = {-sg, -sg};
#pragma unroll
        for (int i = 0; i < 16; i += 2) {
          f32x2 d0 = f32x2{sa[i], sa[i + 1]} - ff0, d1 = f32x2{sb[i], sb[i + 1]} - ff1;
          f32x2 e0 = {__builtin_amdgcn_exp2f(d0[0]), __builtin_amdgcn_exp2f(d0[1])};
          f32x2 e1 = {__builtin_amdgcn_exp2f(d1[0]), __builtin_amdgcn_exp2f(d1[1])};
          f32x2 r = __builtin_elementwise_fma(nsg, e1, e0);
          av[i] = r[0]; av[i + 1] = r[1];
        }
      }
#pragma unroll
      for (int s = 0; s < 2; ++s) {
        u32x4 pp;
        pp.x = pack2(av[8 * s], av[8 * s + 1]); pp.y = pack2(av[8 * s + 2], av[8 * s + 3]);
        pp.z = pack2(av[8 * s + 4], av[8 * s + 5]); pp.w = pack2(av[8 * s + 6], av[8 * s + 7]);
        bf16x8 pb = __builtin_bit_cast(bf16x8, pp);
#pragma unroll
        for (int dvb = 0; dvb < 4; ++dvb) {
          const char* vp = VT + (dvb * 32 + r) * 144 + (kb2 * 32 + 16 * s + 4 * h) * 2;
          u32x2 lo = *(const u32x2*)(vp), hi = *(const u32x2*)(vp + 16);
          u32x4 vv; vv.x = lo.x; vv.y = lo.y; vv.z = hi.x; vv.w = hi.y;
          oacc[dvb] = mma32(__builtin_bit_cast(bf16x8, vv), pb, oacc[dvb]);
        }
      }
    }
  }
  float ss = 0.f;
#pragma unroll
  for (int dvb = 0; dvb < 4; ++dvb)
#pragma unroll
    for (int i = 0; i < 16; ++i) ss += oacc[dvb][i] * oacc[dvb][i];
  ss += __shfl_xor(ss, 32);
  const float rstd = rsqrtf(ss * (1.f / 128.f) + 1e-6f) * 0.8f;
  u16* MIX = (u16*)(p.ws + OFF_MIX) + (size_t)tq * 1024 + 512 + head * 128;
#pragma unroll
  for (int dvb = 0; dvb < 4; ++dvb)
#pragma unroll
    for (int g = 0; g < 4; ++g) {
      int dv = dvb * 32 + 8 * g + 4 * h;
      float4 dn = *(const float4*)(p.diff_norm + dv);
      u32x2 o;
      o.x = pack2(oacc[dvb][4 * g] * rstd * dn.x, oacc[dvb][4 * g + 1] * rstd * dn.y);
      o.y = pack2(oacc[dvb][4 * g + 2] * rstd * dn.z, oacc[dvb][4 * g + 3] * rstd * dn.w);
      *(u32x2*)(MIX + dv) = o;
    }
  __syncthreads();
}

DI void mixer_phase(CP pp, int wv, int rep) {
  const P p = ldp(pp);
  int* ctr = (int*)(p.ws + OFF_CTR) + rep;
  int* cur = (int*)(dsm + LDS_BYTES - 16);
  while (true) {
    __syncthreads();
    if (ltid(wv) == 0) *cur = atomicAdd(ctr, 1);
    __syncthreads();
    int it = *cur;
    __syncthreads();
    if (it >= 768 + 592) break;
    if (it >= 768) {
      const int id = it - 768;
      if (id < 64) transpose_tile(p.w_out, 1024, (u16*)(p.ws + OFF_WB4), 1024, (id % 4) * 256, (id / 4) * 64, 0, wv);
      else if (id < 64 + 352) { const int j = id - 64; transpose_tile(p.w_ffn2_in, 5632, (u16*)(p.ws + OFF_WB5), 1024, (j % 22) * 256, (j / 22) * 64, 1, wv); }
      else { const int j = id - 416; transpose_tile(p.w_ffn2_out, 1024, (u16*)(p.ws + OFF_WB6), DFF, (j % 4) * 256, (j / 4) * 64, 0, wv); }
      continue;
    }
    if (it < 64) { for (int r2 = 0; r2 < DN_REP; ++r2) deltanet_item(p, 512 + it, wv); }
    else if (it < 128) { for (int r2 = 0; r2 < AT_REP; ++r2) attn_item(p, it - 64, wv); }
    else if (it < 640) { for (int r2 = 0; r2 < DN_REP; ++r2) deltanet_item(p, it - 128, wv); }
    else { for (int r2 = 0; r2 < AT_REP; ++r2) attn_item(p, it - 640 + 64, wv); }
  }
}

DI void combine_phase(CP pp, int wv) {
  const P p = ldp(pp);
  const int tidc = ltid(wv), lane = tidc & 63, wid = tidc >> 6;
  const u16* OB = (const u16*)(p.ws + OFF_HID);
  const u16* ZA = (const u16*)(p.ws + OFF_ZA);
  u16* MIX = (u16*)(p.ws + OFF_MIX);
  const int e0 = (lane & 7) * 8;
  const float4 dn0 = *(const float4*)(p.delta_norm + e0), dn1 = *(const float4*)(p.delta_norm + e0 + 4);
  for (int w = blockIdx.x * 8 + wid; w < 2048; w += gridDim.x * 8)
  for (int half = 0; half < 1; ++half) {
    u32x4 a[6][2]; u32x4 z[6];
#pragma unroll
    for (int rr = 0; rr < 6; ++rr) {
      const int t = w * 6 + rr;
      const size_t idx = (size_t)t * 512 + lane * 8;
      a[rr][0] = *(const u32x4*)(OB + idx);
      a[rr][1] = *(const u32x4*)(OB + (size_t)T_TOK * 512 + idx);
      z[rr] = *(const u32x4*)(ZA + (size_t)t * 2048 + 1536 + lane * 8);
    }
#pragma unroll
    for (int rr = 0; rr < 6; ++rr) {
      const int t = w * 6 + rr;
      float o[8];
      {
        const unsigned fa[4] = {a[rr][0].x, a[rr][0].y, a[rr][0].z, a[rr][0].w}, fb[4] = {a[rr][1].x, a[rr][1].y, a[rr][1].z, a[rr][1].w};
#pragma unroll
        for (int i = 0; i < 4; ++i) {
          o[2 * i] = __uint_as_float(fa[i] << 16) + __uint_as_float(fb[i] << 16);
          o[2 * i + 1] = __uint_as_float(fa[i] & 0xffff0000u) + __uint_as_float(fb[i] & 0xffff0000u);
        }
      }
      float ss = 0.f;
#pragma unroll
      for (int i = 0; i < 8; ++i) ss += o[i] * o[i];
      ss = oct_sum(ss);
      const float rstd = rsqrtf(ss * (1.f / 64.f) + 1e-6f);
      const float dnv[8] = {dn0.x, dn0.y, dn0.z, dn0.w, dn1.x, dn1.y, dn1.z, dn1.w};
      const unsigned zz[4] = {z[rr].x, z[rr].y, z[rr].z, z[rr].w};
      float y[8];
#pragma unroll
      for (int i = 0; i < 8; ++i) {
        float zv = (i & 1) ? __uint_as_float(zz[i >> 1] & 0xffff0000u) : __uint_as_float(zz[i >> 1] << 16);
        y[i] = o[i] * rstd * dnv[i] * siluf(zv);
      }
      u32x4 r; r.x = pack2(y[0], y[1]); r.y = pack2(y[2], y[3]); r.z = pack2(y[4], y[5]); r.w = pack2(y[6], y[7]);
      *(u32x4*)(MIX + (size_t)t * 1024 + lane * 8) = r;
    }
  }
}

DI void deferred_w23(CP pp, int wv) {
  const P p = ldp(pp);
  const int ntiles = 48 * 22, rem = ntiles % (int)gridDim.x;
  int first, stride;
  if (rem == 0) { first = blockIdx.x; stride = gridDim.x; }
  else { if ((int)blockIdx.x < rem) return; first = blockIdx.x - rem; stride = gridDim.x - rem; }
  for (int id = first; id < 176 + 240; id += stride) {
    if (id < 176) transpose_tile(p.w_ffn1_out, 1024, (u16*)(p.ws + OFF_WB2), DFF, (id % 4) * 256, (id / 4) * 64, 0, wv);
    else { const int j = id - 176; transpose_tile(p.w_in, 3616, (u16*)(p.ws + OFF_WB3), 1024, (j % 15) * 256, (j / 15) * 64, 2, wv); }
  }
  phase0(pp, wv, first, stride);
}

DI void gemm_dispatch(CP pp, int wv, int which) {
  const P p = ldp(pp);
  const u16* XN = (const u16*)(p.ws + OFF_XN);
  u16* HID = (u16*)(p.ws + OFF_HID);
  const float* MOD = (const float*)(p.ws + OFF_MOD);
  float* Y = p.out + OUT_Y;
  switch (which) {
    case 2: gemm_phase<4>(XN, (const u16*)(p.ws + OFF_WB1), 1024, 48, 22, EpiSwiGLU{HID}, wv); break;
    case 3: gemm_phase<3>(HID, (const u16*)(p.ws + OFF_WB2), DFF, 64, 4, EpiResid192{p.x_prompt, p.x_sample, Y, MOD, 2, 0.5f}, wv); break;
    case 5: gemm_phase<4>(XN, (const u16*)(p.ws + OFF_WB3), 1024, 48, 15, EpiInProj{p.ws, p.out}, wv); break;
    case 8: gemm_phase<3>((const u16*)(p.ws + OFF_MIX), (const u16*)(p.ws + OFF_WB4), 1024, 64, 4, EpiResid192{Y, Y + (size_t)T_P * 1024, Y, MOD, 5, 1.0f}, wv); break;
    case 10: gemm_phase<4>(XN, (const u16*)(p.ws + OFF_WB5), 1024, 48, 22, EpiSwiGLU{HID}, wv); break;
    case 11: gemm_phase<3>(HID, (const u16*)(p.ws + OFF_WB6), DFF, 64, 4, EpiResid192{Y, Y + (size_t)T_P * 1024, Y, MOD, 8, 0.5f}, wv); break;
  }
}

__global__ void __launch_bounds__(512, 2) mega(P pv) {
  cg::grid_group grid = cg::this_grid();
  CP pp = (CP)__builtin_amdgcn_kernarg_segment_ptr();
  const int wv = __builtin_amdgcn_readfirstlane(threadIdx.x >> 6);
  const int plo = pp->plo, phi = pp->phi;
  if (phi > 1000) grid.sync();
  gbar_post(pp, wv);
#ifdef EXTRA_SYNCS
  for (int i = 0; i < EXTRA_SYNCS; ++i) gbar(pp, wv);
#endif
  for (int ph = plo; ph <= phi; ++ph) {
    const int reps = ((REPEAT_MASK >> ph) & 1) ? 2 : 1;
    for (int rep = 0; rep < reps; ++rep) {
    if (ph > plo || rep > 0) gbar(pp, wv);
    switch (ph) {
      case 0: phase0(pp, wv); break;
      case 1: norm_phase<0>(pp, wv); break;
      case 4: norm_phase<1>(pp, wv); break;
      case 6: conv_phase(pp, wv); gbar(pp, wv); mixer_phase(pp, wv, rep); break;
      case 7: combine_phase(pp, wv); break;
      case 9: norm_phase<2>(pp, wv); break;
      case 12: norm_phase<3>(pp, wv); break;
      default: gemm_dispatch(pp, wv, ph); if (ph == 2 && rep == 0) deferred_w23(pp, wv); break;
    }
    }
  }
}

extern "C" void kernel_launch(void* const* d_in, const int* in_sizes, int n_in, void* d_out, int out_size,
                              void* d_ws, size_t ws_size, hipStream_t stream) {
  static int grid_blocks = 0;
  if (!grid_blocks) {
    int dev = 0, cus = 0, per_cu = 0;
    hipGetDevice(&dev);
    hipDeviceGetAttribute(&cus, hipDeviceAttributeMultiprocessorCount, dev);
    hipFuncSetAttribute((const void*)mega, hipFuncAttributeMaxDynamicSharedMemorySize, LDS_BYTES);
    hipOccupancyMaxActiveBlocksPerMultiprocessor(&per_cu, (const void*)mega, 512, LDS_BYTES);
    if (per_cu < 1) per_cu = 1;
    grid_blocks = cus * per_cu;
    if (grid_blocks > 256) grid_blocks = 256;
    grid_blocks &= ~7;
    if (ws_size < WS_END) fprintf(stderr, "workspace too small: %zu < %zu\n", ws_size, (size_t)WS_END);
  }
  hipMemsetAsync((char*)d_ws + OFF_BAR, 0, 16384, stream);
  P p{};
  const float** f = (const float**)&p;
  for (int i = 0; i < 28; ++i) f[i] = (const float*)d_in[i];
  p.out = (float*)d_out; p.ws = (char*)d_ws;
#if MK_MULTI
  for (int ph = 0; ph <= 12; ++ph) {
    p.plo = ph; p.phi = ph;
    hipLaunchKernelGGL(mega, dim3(grid_blocks), dim3(512), LDS_BYTES, stream, p);
  }
#else
  p.plo = 0; p.phi = 12;
  void* args[] = {&p};
  hipError_t e = hipLaunchCooperativeKernel((const void*)mega, dim3(grid_blocks), dim3(512), args, LDS_BYTES, stream);
  if (e != hipSuccess) fprintf(stderr, "cooperative launch failed: %s (grid %d)\n", hipGetErrorString(e), grid_blocks);
#endif
}
```

```cpp
#include <hip/hip_runtime.h>
#include <hip/hip_cooperative_groups.h>
#include <cstdio>
namespace cg = cooperative_groups;

#ifndef DN_REP
#define DN_REP 1
#endif
#ifndef AT_REP
#define AT_REP 1
#endif
#ifndef REPEAT_MASK
#define REPEAT_MASK 0
#endif
#ifndef MK_MULTI
#define MK_MULTI 0
#endif

#define DI __device__ __forceinline__
typedef unsigned short u16;
using bf16x8 = __attribute__((ext_vector_type(8))) short;
using s16x4  = __attribute__((ext_vector_type(4))) short;
using f32x4  = __attribute__((ext_vector_type(4))) float;
using f32x2  = __attribute__((ext_vector_type(2))) float;
using f32x16 = __attribute__((ext_vector_type(16))) float;
using u32x2  = __attribute__((ext_vector_type(2))) unsigned;
using u32x4  = __attribute__((ext_vector_type(4))) unsigned;

extern __shared__ __attribute__((aligned(16))) char dsm[];

constexpr int T_TOK = 12288, T_P = 8192, DM = 1024, DFF = 2816;
constexpr int NKS = 16;
constexpr int LDS_BYTES = 131072 + 64;

constexpr size_t OFF_WB1 = 0;
constexpr size_t OFF_WB2 = OFF_WB1 + 11534336;
constexpr size_t OFF_WB3 = OFF_WB2 + 5767168;
constexpr size_t OFF_WB4 = OFF_WB3 + 7864320;
constexpr size_t OFF_WB5 = OFF_WB4 + 2097152;
constexpr size_t OFF_WB6 = OFF_WB5 + 11534336;
constexpr size_t OFF_MODP = OFF_WB6 + 5767168;
constexpr size_t OFF_MOD = OFF_MODP + (size_t)NKS * 5 * 9216 * 4;
constexpr size_t OFF_ROPE = OFF_MOD + 5 * 9216 * 4;
constexpr size_t OFF_CTR = OFF_ROPE + 8192;
constexpr size_t OFF_GB = OFF_CTR + 256;
constexpr size_t OFF_XN = OFF_GB + (size_t)T_TOK * 32 * 4;
constexpr size_t OFF_MIX = OFF_XN + (size_t)T_TOK * 1024 * 2;
constexpr size_t OFF_HID = OFF_MIX + (size_t)T_TOK * 1024 * 2;
constexpr size_t OFF_ZA = OFF_HID + (size_t)T_TOK * DFF * 2;
constexpr size_t OFF_Q = OFF_ZA + (size_t)T_TOK * 2048 * 2;
constexpr size_t OFF_KP = OFF_Q + (size_t)T_TOK * 512 * 2;
constexpr size_t OFF_KS = OFF_KP + (size_t)T_P * 512 * 2;
constexpr size_t OFF_VTP = OFF_KS + (size_t)4 * 1280 * 512 * 2;
constexpr size_t OFF_VTS = OFF_VTP + (size_t)T_P * 512 * 2;
constexpr size_t OFF_BAR = OFF_VTS + (size_t)4 * 1280 * 512 * 2;
constexpr size_t WS_END = OFF_BAR + 16384;

constexpr size_t OUT_Y = 0;
constexpr size_t OUT_K = 12582912;
constexpr size_t OUT_V = 16777216;
constexpr size_t OUT_S = 20971520;

struct P {
  const float *x_prompt, *x_sample, *cache_k, *cache_v, *state, *c, *c_ctx, *w_ada, *b_ada,
      *norm_ffn1, *w_ffn1_in, *w_ffn1_out, *norm_mix, *w_in, *conv_w, *a_log, *dt_bias, *delta_norm,
      *lq1, *lk1, *lq2, *lk2, *diff_norm, *w_out, *norm_ffn2, *w_ffn2_in, *w_ffn2_out, *norm_final;
  float* out;
  char* ws;
  int plo, phi;
};

DI u16 f2bf(float x) { return __builtin_bit_cast(u16, (__bf16)x); }
DI float bf2f(u16 b) { return __uint_as_float(((unsigned)b) << 16); }
DI unsigned pack2(float a, float b) { return (unsigned)f2bf(a) | ((unsigned)f2bf(b) << 16); }
#define DPPF(v, ctrl, rmask) __int_as_float(__builtin_amdgcn_update_dpp(0, __float_as_int(v), ctrl, rmask, 0xf, false))
DI float wave_sum(float v) {
  v += DPPF(v, 0xB1, 0xf); v += DPPF(v, 0x4E, 0xf); v += DPPF(v, 0x141, 0xf); v += DPPF(v, 0x140, 0xf);
  v += DPPF(v, 0x142, 0xa); v += DPPF(v, 0x143, 0xc);
  return __int_as_float(__builtin_amdgcn_readlane(__float_as_int(v), 63));
}
DI float quad_bcast(float v, int k) {
  switch (k & 3) {
    case 0: return DPPF(v, 0x00, 0xf);
    case 1: return DPPF(v, 0x55, 0xf);
    case 2: return DPPF(v, 0xAA, 0xf);
    default: return DPPF(v, 0xFF, 0xf);
  }
}
DI float oct_sum(float v) {
  v += DPPF(v, 0xB1, 0xf); v += DPPF(v, 0x4E, 0xf); v += DPPF(v, 0x141, 0xf);
  return v;
}
typedef const P __attribute__((address_space(4)))* CP;
typedef const unsigned long long __attribute__((address_space(4)))* CU64;
DI int ltid(int wv) { unsigned m = ~0u; asm volatile("" : "+s"(m)); int t = wv * 64 + (int)__builtin_amdgcn_mbcnt_hi(m, __builtin_amdgcn_mbcnt_lo(m, 0u)); asm volatile("" : "+v"(t)); return t; }
DI P ldp(CP pp) {
  asm volatile("" : "+s"(pp));
  P p; CU64 s = (CU64)pp; unsigned long long* d = (unsigned long long*)&p;
#pragma unroll
  for (int i = 0; i < 31; ++i) d[i] = s[i];
  return p;
}

#define XB_TMO      128
#define XB_XCNT(j)  (256  + 64 * (j))
#define XB_XSUB(j)  (1280 + 64 * (j))
#define XB_XGEN(j)  (2304 + 64 * (j))
#define XB_TOP      3328
#define XB_TOPGEN   3392
#define XCD_BAR_WORDS 3456
#define XB_SPIN_CAP (1u << 20)
DI unsigned xb_ld(unsigned* p) { return __hip_atomic_load(p, __ATOMIC_RELAXED, __HIP_MEMORY_SCOPE_AGENT); }
DI unsigned xb_add(unsigned* p, unsigned v) { return __hip_atomic_fetch_add(p, v, __ATOMIC_RELAXED, __HIP_MEMORY_SCOPE_AGENT); }
DI unsigned xb_xcc_id() { return (unsigned)__builtin_amdgcn_s_getreg((3 << 11) | 20) & 0xFu; }
#define XB_SPIN(cond, bar) do { unsigned _sp = 0; while (cond) { __builtin_amdgcn_s_sleep(1); \
    if ((++_sp & 255u) == 0u) { if (xb_ld(&(bar)[XB_TMO])) break; if (_sp > XB_SPIN_CAP) { atomicAdd(&(bar)[XB_TMO], 1u); break; } } } } while (0)
DI void xcd_barrier_complete(unsigned* bar, unsigned x, unsigned& nloc, unsigned& nx) {
  const unsigned G = gridDim.x;
  unsigned sum, cnt, mine, sp = 0u;
  for (;;) {
    sum = 0u; cnt = 0u; mine = 0u;
#pragma unroll
    for (unsigned j = 0; j < 16; ++j) { const unsigned c = xb_ld(&bar[XB_XCNT(j)]); sum += c; cnt += (c > 0u) ? 1u : 0u; mine = (j == x) ? c : mine; }
    if (sum == G) break;
    __builtin_amdgcn_s_sleep(1);
    if ((++sp & 255u) == 0u) { if (xb_ld(&bar[XB_TMO])) break; if (sp > XB_SPIN_CAP) { atomicAdd(&bar[XB_TMO], 1u); break; } }
  }
  nloc = mine > 0u ? mine : 1u; nx = cnt > 0u ? cnt : 1u;
}
DI void gbar_post(CP pp, int wv) {
  volatile unsigned* st = (volatile unsigned*)(dsm + LDS_BYTES - 32);
  if (ltid(wv) == 0) {
    unsigned* bar = (unsigned*)(pp->ws + OFF_BAR);
    st[0] = 0u; st[1] = 0u;
    (void)xb_add(&bar[XB_XCNT(xb_xcc_id())], 1u);
  }
  __syncthreads();
}
DI void gbar(CP pp, int wv) {
  asm volatile("s_waitcnt vmcnt(0)" ::: "memory");
  __syncthreads();
  if (ltid(wv) == 0) {
    unsigned* bar = (unsigned*)(pp->ws + OFF_BAR);
    volatile unsigned* st = (volatile unsigned*)(dsm + LDS_BYTES - 32);
    const unsigned x = xb_xcc_id();
    __builtin_amdgcn_s_waitcnt(0);
    unsigned nloc = st[0], nx = st[1];
    if (nloc == 0u) { xcd_barrier_complete(bar, x, nloc, nx); st[0] = nloc; st[1] = nx; }
    const unsigned old = xb_add(&bar[XB_XSUB(x)], 1u);
    const unsigned gen = old / nloc;
    if (old + 1u == (gen + 1u) * nloc) {
      __builtin_amdgcn_fence(__ATOMIC_RELEASE, "agent");
      asm volatile("s_waitcnt vmcnt(0)" ::: "memory");
      const unsigned og = xb_add(&bar[XB_TOP], 1u);
      const unsigned tg = og / nx;
      if (og + 1u == (tg + 1u) * nx) xb_add(&bar[XB_TOPGEN], 1u);
      else XB_SPIN(xb_ld(&bar[XB_TOPGEN]) == tg, bar);
      __builtin_amdgcn_fence(__ATOMIC_ACQUIRE, "agent");
      xb_add(&bar[XB_XGEN(x)], 1u);
      asm volatile("s_waitcnt vmcnt(0)" ::: "memory");
    } else {
      XB_SPIN(xb_ld(&bar[XB_XGEN(x)]) == gen, bar);
      __builtin_amdgcn_fence(__ATOMIC_ACQUIRE, "agent");
      asm volatile("s_waitcnt vmcnt(0)" ::: "memory");
    }
  }
  __syncthreads();
}
DI float4 nt_load4(const float* p) { f32x4 v = __builtin_nontemporal_load((const f32x4*)p); return make_float4(v[0], v[1], v[2], v[3]); }
DI void nt_store4(float4 v, float* p) { f32x4 t = {v.x, v.y, v.z, v.w}; __builtin_nontemporal_store(t, (f32x4*)p); }
DI float siluf(float x) { return x * __builtin_amdgcn_rcpf(1.f + __builtin_amdgcn_exp2f(-1.4426950408889634f * x)); }
DI int tok_group(int t) { return t < T_P ? 0 : 1 + ((t - T_P) >> 10); }

DI void transpose_tile(const float* __restrict__ src, int nsrc, u16* __restrict__ dst, int K, int n0, int k0, int mode, int wv) {
  float* tl = (float*)dsm;
  const int tid = ltid(wv);
  float4 v[8];
#pragma unroll
  for (int i = 0; i < 8; ++i) {
    int e = tid + 512 * i;
    int k = e >> 6, n = n0 + (e & 63) * 4, sc;
    if (mode == 1 || (mode == 2 && (n < 2048 || (n >= 3072 && n < 3584)))) { const int rho = n & 31, nf = rho >> 4, i = rho & 15; n = (n & ~31) + 8 * (i >> 2) + 4 * nf + (i & 3); }
    if (mode == 1) { int pp = n >> 8, w = n & 255; sc = (w >> 7) * DFF + pp * 128 + (w & 127); }
    else if (mode == 2) { sc = n < 2048 ? n : (n < 3584 ? n + 32 : (n < 3616 ? n - 3584 + 2048 : -1)); }
    else sc = n;
    v[i] = sc >= 0 ? nt_load4(src + (size_t)(k0 + k) * nsrc + sc) : make_float4(0.f, 0.f, 0.f, 0.f);
  }
#pragma unroll
  for (int i = 0; i < 8; ++i) {
    int e = tid + 512 * i;
    int k = e >> 6, j = (e & 63) * 4;
    tl[k * 257 + j] = v[i].x; tl[k * 257 + j + 1] = v[i].y; tl[k * 257 + j + 2] = v[i].z; tl[k * 257 + j + 3] = v[i].w;
  }
  __syncthreads();
#pragma unroll
  for (int i = 0; i < 8; ++i) {
    int e = tid + 512 * i;
    int n = e >> 4, kq = (e & 15) * 4;
    u32x2 o;
    o.x = pack2(tl[kq * 257 + n], tl[(kq + 1) * 257 + n]);
    o.y = pack2(tl[(kq + 2) * 257 + n], tl[(kq + 3) * 257 + n]);
    *(u32x2*)(dst + (size_t)(n0 + n) * K + k0 + kq) = o;
  }
  __syncthreads();
}

DI void phase0(CP pp, int wv, int misc_first = -1, int misc_stride = 1) {
  const P p = ldp(pp);
  const bool misc = misc_first >= 0;
  const int tid = ltid(wv);
  u16* WB1 = (u16*)(p.ws + OFF_WB1); u16* WB2 = (u16*)(p.ws + OFF_WB2); u16* WB3 = (u16*)(p.ws + OFF_WB3);
  u16* WB4 = (u16*)(p.ws + OFF_WB4); u16* WB5 = (u16*)(p.ws + OFF_WB5); u16* WB6 = (u16*)(p.ws + OFF_WB6);
  float* MODP = (float*)(p.ws + OFF_MODP);
  constexpr int NA = 256;
  constexpr int S1 = NA, S2 = S1 + 352, S3 = S2 + 176, S4 = S3 + 240, S5 = S4 + 64, S6 = S5 + 352, S7 = S6 + 176;
  constexpr int S8 = S7 + 1, S9 = S8 + 16, S10 = S9 + 16;
  for (int it = misc ? S7 + misc_first : (int)blockIdx.x; it < (misc ? S10 : S2); it += misc ? misc_stride : (int)gridDim.x) {
    if (it >= S2 && it < S7) continue;
    if (it < NA) {
      float* sl = (float*)dsm;
      float* red = sl + 5120;
      __syncthreads();
      for (int e = tid; e < 5120; e += 512) {
        int g = e >> 10, k = e & 1023;
        float v = g == 0 ? p.c_ctx[k] : p.c[(g - 1) * 1024 + k];
        sl[e] = v / (1.f + expf(-v));
      }
      __syncthreads();
      const int c0 = it * 36;
      if (tid < 504) {
        const int kg = tid / 36, col = tid - kg * 36;
        float a0 = 0, a1 = 0, a2 = 0, a3 = 0, a4 = 0;
        const float* wp = p.w_ada + c0 + col;
#pragma unroll 1
        for (int i0 = 0; i0 < 74; i0 += 19) {
          float wv_[19];
#pragma unroll
          for (int j = 0; j < 19; ++j) { const int k = kg + 14 * (i0 + j); wv_[j] = (i0 + j < 74 && k < 1024) ? __builtin_nontemporal_load(wp + (size_t)k * 9216) : 0.f; }
#pragma unroll
          for (int j = 0; j < 19; ++j) {
            const int k = min(kg + 14 * (i0 + j), 1023); const float w = wv_[j];
            a0 += sl[k] * w; a1 += sl[1024 + k] * w; a2 += sl[2048 + k] * w; a3 += sl[3072 + k] * w; a4 += sl[4096 + k] * w;
          }
        }
        float* r = red + (kg * 36 + col) * 5;
        r[0] = a0; r[1] = a1; r[2] = a2; r[3] = a3; r[4] = a4;
      }
      __syncthreads();
      if (tid < 180) {
        const int col = tid / 5, g = tid - col * 5;
        float a = p.b_ada[c0 + col];
#pragma unroll
        for (int kg = 0; kg < 14; ++kg) a += red[(kg * 36 + col) * 5 + g];
        ((float*)(p.ws + OFF_MOD))[g * 9216 + c0 + col] = a;
      }
      __syncthreads();
    } else if (it < S2) { int id = it - S1; transpose_tile(p.w_ffn1_in, 5632, WB1, 1024, (id % 22) * 256, (id / 22) * 64, 1, wv); }
    else if (it < S3) { int id = it - S2; transpose_tile(p.w_ffn1_out, 1024, WB2, DFF, (id % 4) * 256, (id / 4) * 64, 0, wv); }
    else if (it < S4) { int id = it - S3; transpose_tile(p.w_in, 3616, WB3, 1024, (id % 15) * 256, (id / 15) * 64, 2, wv); }
    else if (it < S5) { int id = it - S4; transpose_tile(p.w_out, 1024, WB4, 1024, (id % 4) * 256, (id / 4) * 64, 0, wv); }
    else if (it < S6) { int id = it - S5; transpose_tile(p.w_ffn2_in, 5632, WB5, 1024, (id % 22) * 256, (id / 22) * 64, 1, wv); }
    else if (it < S7) { int id = it - S6; transpose_tile(p.w_ffn2_out, 1024, WB6, DFF, (id % 4) * 256, (id / 4) * 64, 0, wv); }
    else if (it < S8) {
      float* rope = (float*)(p.ws + OFF_ROPE);
      for (int e = tid; e < 1024; e += 512) {
        int pos = e >> 4, i = e & 15;
        float inv = powf(10000.f, -(float)i / 16.f);
        float ang = (float)pos * inv;
        rope[e] = cosf(ang); rope[1024 + e] = sinf(ang);
      }
      if (tid < 4) ((int*)(p.ws + OFF_CTR))[tid] = 0;
    } else if (it < S9) {
      int id = it - S8;
      u16* KS = (u16*)(p.ws + OFF_KS);
      for (int e = tid; e < 64 * 256; e += 512) {
        int rr = id * 64 + (e >> 8), c2 = (e & 255) * 2;
        int b = rr >> 8, j = rr & 255;
        const float* s = p.cache_k + (size_t)rr * 512 + c2;
        const int rho = c2 & 31, cp2 = (c2 & ~31) + 8 * ((rho & 15) >> 2) + 4 * (rho >> 4) + (rho & 3);
        *(unsigned*)(KS + ((size_t)b * 1280 + j) * 512 + cp2) = pack2(s[0], s[1]);
      }
    } else {
      int id = it - S9;
      u16* VS = (u16*)(p.ws + OFF_VTS);
      for (int e = tid; e < 64 * 256; e += 512) {
        int rr = id * 64 + (e >> 8), c2 = (e & 255) * 2;
        int b = rr >> 8, j = rr & 255;
        const float* s = p.cache_v + (size_t)rr * 512 + c2;
        *(unsigned*)(VS + ((size_t)b * 1280 + j) * 512 + c2) = pack2(s[0], s[1]);
      }
    }
  }
}

template <int which>
DI void norm_phase(CP pp, int wv) {
  const P p = ldp(pp);
  const int tid = ltid(wv), lane = tid & 63, wid = tid >> 6;
  const float* MODP = (const float*)(p.ws + OFF_MODP);
  float* MOD = (float*)(p.ws + OFF_MOD);
  u16* XN = (u16*)(p.ws + OFF_XN);
  const float* gain = which == 0 ? p.norm_ffn1 : which == 1 ? p.norm_mix : which == 2 ? p.norm_ffn2 : p.norm_final;
  constexpr int s_shift = which == 0 ? 0 : which == 1 ? 3 : 6;
  float4 gn[4], sh[4], sc[4];
#pragma unroll
  for (int i = 0; i < 4; ++i) gn[i] = *(const float4*)(gain + i * 256 + lane * 4);
  int gcur = -1;
  for (int w = blockIdx.x * 8 + wid; w < 2048; w += gridDim.x * 8)
  for (int half = 0; half < 1; ++half) {
    const int t0 = w * 6;
    if (which != 3) {
      const int g0 = tok_group(t0);
      if (g0 != gcur) {
        gcur = g0;
#pragma unroll
        for (int i = 0; i < 4; ++i) {
          sh[i] = *(const float4*)(MOD + (g0 * 9 + s_shift) * 1024 + i * 256 + lane * 4);
          sc[i] = *(const float4*)(MOD + (g0 * 9 + s_shift + 1) * 1024 + i * 256 + lane * 4);
        }
      }
    }
    float4 xv[6][4];
#pragma unroll
    for (int rr = 0; rr < 6; ++rr) {
      const int t = t0 + rr;
      const float* xr = which == 0 ? (t < T_P ? p.x_prompt + (size_t)t * 1024 : p.x_sample + (size_t)(t - T_P) * 1024)
                                   : p.out + OUT_Y + (size_t)t * 1024;
#pragma unroll
      for (int i = 0; i < 4; ++i) xv[rr][i] = *(const float4*)(xr + i * 256 + lane * 4);
    }
#pragma unroll
    for (int rr = 0; rr < 6; ++rr) {
      const int t = t0 + rr;
      float ss = 0.f;
#pragma unroll
      for (int i = 0; i < 4; ++i) ss += xv[rr][i].x * xv[rr][i].x + xv[rr][i].y * xv[rr][i].y + xv[rr][i].z * xv[rr][i].z + xv[rr][i].w * xv[rr][i].w;
      ss = wave_sum(ss);
      const float rstd = rsqrtf(ss * (1.f / 1024.f) + 1e-6f);
      if (which == 3) {
        float* orow = p.out + OUT_Y + (size_t)t * 1024;
#pragma unroll
        for (int i = 0; i < 4; ++i) {
          float4 o;
          o.x = xv[rr][i].x * rstd * gn[i].x; o.y = xv[rr][i].y * rstd * gn[i].y;
          o.z = xv[rr][i].z * rstd * gn[i].z; o.w = xv[rr][i].w * rstd * gn[i].w;
          nt_store4(o, orow + i * 256 + lane * 4);
        }
      } else {
        const int g = tok_group(t);
        if (g != gcur) {
          gcur = g;
#pragma unroll
          for (int i = 0; i < 4; ++i) {
            const int col = i * 256 + lane * 4;
            {
              sh[i] = *(const float4*)(MOD + (g * 9 + s_shift) * 1024 + col);
              sc[i] = *(const float4*)(MOD + (g * 9 + s_shift + 1) * 1024 + col);
            }
          }
        }
#pragma unroll
        for (int i = 0; i < 4; ++i) {
          float y0 = xv[rr][i].x * rstd * gn[i].x * (1.f + sc[i].x) + sh[i].x;
          float y1 = xv[rr][i].y * rstd * gn[i].y * (1.f + sc[i].y) + sh[i].y;
          float y2 = xv[rr][i].z * rstd * gn[i].z * (1.f + sc[i].z) + sh[i].z;
          float y3 = xv[rr][i].w * rstd * gn[i].w * (1.f + sc[i].w) + sh[i].w;
          u32x2 o; o.x = pack2(y0, y1); o.y = pack2(y2, y3);
          *(u32x2*)(XN + (size_t)t * 1024 + i * 256 + lane * 4) = o;
        }
      }
    }
  }
}

constexpr int BM = 256, BK = 64, HALF = 128, HT = HALF * BK;

DI int lds_byte(int r, int c) {
  int st = (r >> 4) * 2 + (c >> 5), rr = r & 15, cc = c & 31, ob = rr * 64 + cc * 2;
  return st * 1024 + (ob ^ (((ob >> 9) & 1) << 5));
}
DI void stage_rc(int b, int& R, int& C) {
  int st = b / 1024, sb = b % 1024, swz = sb ^ (((sb >> 9) & 1) << 5);
  R = (st >> 1) * 16 + swz / 64; C = (st & 1) * 32 + (swz % 64) / 2;
}

template <int MT, class Epi>
DI void gemm_phase(const u16* __restrict__ A, const u16* __restrict__ Bt, const int K, const int nM, const int nN, Epi epi, int wv) {
  u16* shm = (u16*)dsm;
#define SA(b, h) (shm + ((b) * 2 + (h)) * HT)
#define SB(b, h) (shm + (4 + (b) * 2 + (h)) * HT)
#define STAGE(Pp, BASE, br, kt) do { const char* _gb = (const char*)(BASE) + ((size_t)(br) * K + (size_t)(kt) * BK) * 2; \
    __builtin_amdgcn_global_load_lds((const unsigned*)(_gb + voff0), (unsigned*)((char*)(Pp) + tidl * 16), 16, 0, 0); \
    __builtin_amdgcn_global_load_lds((const unsigned*)(_gb + voff1), (unsigned*)((char*)(Pp) + tidl * 16 + 8192), 16, 0, 0); } while (0)
#define LDA(dst, b, h) for (int m = 0; m < MT; ++m) for (int k = 0; k < 2; ++k) \
    dst[m][k] = *reinterpret_cast<const bf16x8*>((char*)SA(b, h) + lds_byte(wr * (MT * 16) + m * 16 + fr, k * 32 + fq * 8))
#define LDB(dst, b, h) for (int n = 0; n < 2; ++n) for (int k = 0; k < 2; ++k) \
    dst[n][k] = *reinterpret_cast<const bf16x8*>((char*)SB(b, h) + lds_byte(wc * 32 + n * 16 + fr, k * 32 + fq * 8))
#define MMA(ai, bj, At_, Bt_) do { __builtin_amdgcn_s_setprio(1); \
    for (int m = 0; m < MT; ++m) for (int n = 0; n < 2; ++n) for (int k = 0; k < 2; ++k) \
      acc[ai][bj][m][n] = __builtin_amdgcn_mfma_f32_16x16x32_bf16(Bt_[n][k], At_[m][k], acc[ai][bj][m][n], 0, 0, 0); \
    __builtin_amdgcn_s_setprio(0); } while (0)
#define WAIT_V(n) asm volatile("s_waitcnt vmcnt(" #n ")" ::: "memory")
#define WAIT_L(n) asm volatile("s_waitcnt lgkmcnt(" #n ")" ::: "memory")
#define WAIT_LA do { if (MT == 4) asm volatile("s_waitcnt lgkmcnt(8)" ::: "memory"); else asm volatile("s_waitcnt lgkmcnt(6)" ::: "memory"); } while (0)
#define BAR __builtin_amdgcn_s_barrier()
#define SCHED __builtin_amdgcn_sched_barrier(0)

  const int ntiles = nM * nN, per = ntiles / 8;
  const int nt = K / BK;
  int tix = blockIdx.x;
  if (tix < ntiles) {
    const int tidl = ltid(wv);
    const int wid = tidl >> 6, lane = tidl & 63, wr = wid >> 2, wc = wid & 3, fr = lane & 15, fq = lane >> 4;
    unsigned voff0, voff1;
    { int _r, _c; stage_rc(tidl * 16, _r, _c); voff0 = (unsigned)(_r * K + _c) * 2u;
      stage_rc(tidl * 16 + 8192, _r, _c); voff1 = (unsigned)(_r * K + _c) * 2u; }
    const int wgm = nM >> 3, nig = wgm * nN;
    int pm, pn;
    { int lid = (tix & 7) * per + (tix >> 3); int grp = lid / nig, within = lid - grp * nig; pm = grp * wgm + within % wgm; pn = within / wgm; }
    int brow = pm * (MT * 64), bcol = pn * BM;
    bf16x8 At[MT][2], B0[2][2], B1[2][2];
    STAGE(SB(0, 0), Bt, bcol, 0); STAGE(SA(0, 0), A, brow, 0);
    STAGE(SB(0, 1), Bt, bcol + HALF, 0); STAGE(SA(0, 1), A, brow + MT * 32, 0);
    if (wr == 1) BAR;
    WAIT_V(4); BAR;
    STAGE(SB(1, 0), Bt, bcol, 1); STAGE(SA(1, 0), A, brow, 1); STAGE(SB(1, 1), Bt, bcol + HALF, 1);
    WAIT_V(6); BAR;
    while (true) {
      const int ntix = tix + gridDim.x;
      const bool has_next = ntix < ntiles;
      int npm, npn;
      { int lid = ((has_next ? ntix : tix) & 7) * per + ((has_next ? ntix : tix) >> 3); int grp = lid / nig, within = lid - grp * nig; npm = grp * wgm + within % wgm; npn = within / wgm; }
      const int nbrow = npm * (MT * 64), nbcol = npn * BM;
      f32x4 acc[2][2][MT][2] = {};
      for (int t = 0; t < nt; t += 2) {
        const bool last = t + 2 >= nt;
        const int rA = last ? nbrow : brow, rB = last ? nbcol : bcol, k2 = last ? 0 : t + 2, k3 = last ? 1 : t + 3;
        LDB(B0, 0, 0); SCHED; LDA(At, 0, 0); STAGE(SA(1, 1), A, brow + MT * 32, t + 1);
        WAIT_LA; BAR; WAIT_L(0); MMA(0, 0, At, B0); BAR; SCHED;
        LDB(B1, 0, 1); STAGE(SB(0, 0), Bt, rB, k2);
        BAR; WAIT_L(0); MMA(0, 1, At, B1); BAR;
        LDA(At, 0, 1); STAGE(SA(0, 0), A, rA, k2);
        BAR; WAIT_L(0); MMA(1, 0, At, B0); BAR; SCHED;
        STAGE(SB(0, 1), Bt, rB + HALF, k2);
        WAIT_V(6); BAR; MMA(1, 1, At, B1); BAR;
        LDB(B0, 1, 0); SCHED; LDA(At, 1, 0); STAGE(SA(0, 1), A, rA + MT * 32, k2);
        WAIT_LA; BAR; WAIT_L(0); MMA(0, 0, At, B0); BAR; SCHED;
        LDB(B1, 1, 1); STAGE(SB(1, 0), Bt, rB, k3);
        BAR; WAIT_L(0); MMA(0, 1, At, B1); BAR;
        LDA(At, 1, 1); STAGE(SA(1, 0), A, rA, k3);
        BAR; WAIT_L(0); MMA(1, 0, At, B0); BAR; SCHED;
        STAGE(SB(1, 1), Bt, rB + HALF, k3);
        WAIT_V(6); BAR; MMA(1, 1, At, B1); BAR;
      }
      {
        int t2 = ltid(wv);
        const int wid2 = t2 >> 6, lane2 = t2 & 63;
        epi(pm, pn, acc, wid2 >> 2, wid2 & 3, lane2 & 15, lane2 >> 4);
      }
      WAIT_V(0);
      if (!has_next) break;
      tix = ntix; pm = npm; pn = npn; brow = nbrow; bcol = nbcol;
    }
    if (wr == 0) BAR;
    __syncthreads();
  }
#undef WAIT_LA
#undef SA
#undef SB
#undef STAGE
#undef LDA
#undef LDB
#undef MMA
}

struct EpiSwiGLU {
  u16* HID;
  DI void operator()(int pm, int pn, f32x4 (&acc)[2][2][4][2], int wr, int wc, int fr, int fq) const {
#pragma unroll
    for (int ai = 0; ai < 2; ++ai)
#pragma unroll
      for (int m = 0; m < 4; ++m) {
        int t = pm * 256 + ai * 128 + wr * 64 + m * 16 + fr;
        {
          const int hc = pn * 128 + wc * 32 + fq * 8;
          f32x4 g0 = acc[ai][0][m][0], u0 = acc[ai][1][m][0], g1 = acc[ai][0][m][1], u1 = acc[ai][1][m][1];
          u32x4 o;
          o.x = pack2(siluf(g0[0]) * u0[0], siluf(g0[1]) * u0[1]);
          o.y = pack2(siluf(g0[2]) * u0[2], siluf(g0[3]) * u0[3]);
          o.z = pack2(siluf(g1[0]) * u1[0], siluf(g1[1]) * u1[1]);
          o.w = pack2(siluf(g1[2]) * u1[2], siluf(g1[3]) * u1[3]);
          *(u32x4*)(HID + (size_t)t * DFF + hc) = o;
        }
      }
  }
};

struct EpiResid {
  const float* xp; const float* xs;
  float* out; const float* MOD; int slot; float coef;
  DI void operator()(int pm, int pn, f32x4 (&acc)[2][2][4][2], int wr, int wc, int fr, int fq) const {
    const int g = pm < 32 ? 0 : 1 + ((pm - 32) >> 2);
    const float* gate = MOD + (g * 9 + slot) * 1024 + pn * 256;
    const float* xin = pm < 32 ? xp + (size_t)pm * 262144 + pn * 256 : xs + (size_t)(pm - 32) * 262144 + pn * 256;
    float* o = out + (size_t)pm * 262144 + pn * 256;
    const unsigned cbase = wc * 32 + fq * 4, rbase = wr * 64 + fr;
#pragma unroll
    for (int bj = 0; bj < 2; ++bj)
#pragma unroll
      for (int n = 0; n < 2; ++n) {
        const unsigned col = cbase + bj * 128 + n * 16;
        const float4 gt = *(const float4*)(gate + col);
#pragma unroll
        for (int aim = 0; aim < 4; ++aim) {
          const int ai = aim >> 1;
          asm volatile("" ::: "memory");
          float4 xi[2][4];
#pragma unroll
          for (int m = (aim & 1) * 2; m < (aim & 1) * 2 + 2; ++m) xi[ai][m] = *(const float4*)(xin + (rbase + ai * 128 + m * 16) * 1024u + col);
#pragma unroll
          for (int m = (aim & 1) * 2; m < (aim & 1) * 2 + 2; ++m) {
            const unsigned off = (rbase + ai * 128 + m * 16) * 1024u + col;
            f32x4 a = acc[ai][bj][m][n];
            float4 r;
            r.x = xi[ai][m].x + coef * gt.x * a[0]; r.y = xi[ai][m].y + coef * gt.y * a[1];
            r.z = xi[ai][m].z + coef * gt.z * a[2]; r.w = xi[ai][m].w + coef * gt.w * a[3];
            *(float4*)(o + off) = r;
          }
        }
      }
  }
};

struct EpiResid192 {
  const float* xp; const float* xs; float* out; const float* MOD; int slot; float coef;
  DI void operator()(int pm, int pn, f32x4 (&acc)[2][2][3][2], int wr, int wc, int fr, int fq) const {
    const unsigned cbase = pn * 256 + wc * 32 + fq * 4;
#pragma unroll
    for (int bj = 0; bj < 2; ++bj) {
      asm volatile("" ::: "memory");
      float4 xi[2][3][2];
#pragma unroll
      for (int ai = 0; ai < 2; ++ai)
#pragma unroll
        for (int m = 0; m < 3; ++m) {
          const int t = pm * 192 + ai * 96 + wr * 48 + m * 16 + fr;
          const float* xin = t < T_P ? xp + (size_t)t * 1024 : xs + (size_t)(t - T_P) * 1024;
#pragma unroll
          for (int n = 0; n < 2; ++n) xi[ai][m][n] = *(const float4*)(xin + cbase + bj * 128 + n * 16);
        }
#pragma unroll
      for (int ai = 0; ai < 2; ++ai)
#pragma unroll
        for (int m = 0; m < 3; ++m) {
          const int t = pm * 192 + ai * 96 + wr * 48 + m * 16 + fr;
          const float* gate = MOD + (tok_group(t) * 9 + slot) * 1024;
          float* o = out + (size_t)t * 1024;
#pragma unroll
          for (int n = 0; n < 2; ++n) {
            const float4 gt = *(const float4*)(gate + cbase + bj * 128 + n * 16);
            f32x4 a = acc[ai][bj][m][n];
            float4 r;
            r.x = xi[ai][m][n].x + coef * gt.x * a[0]; r.y = xi[ai][m][n].y + coef * gt.y * a[1];
            r.z = xi[ai][m][n].z + coef * gt.z * a[2]; r.w = xi[ai][m][n].w + coef * gt.w * a[3];
            *(float4*)(o + cbase + bj * 128 + n * 16) = r;
          }
        }
    }
  }
};

struct EpiInProj {
  char* ws; float* out;
  DI void operator()(int pm, int pn, f32x4 (&acc)[2][2][4][2], int wr, int wc, int fr, int fq) const {
    const bool sample = pm >= 32;
    const unsigned rbase = wr * 64 + fr;
    const unsigned cb0 = wc * 32 + fq * 4;
    if (pn < 8) {
      u16* ZA = (u16*)(ws + OFF_ZA) + (size_t)pm * 256 * 2048 + pn * 256;
#pragma unroll
      for (int ai = 0; ai < 2; ++ai)
#pragma unroll
        for (int m = 0; m < 4; ++m)
#pragma unroll
          for (int bj = 0; bj < 2; ++bj) {
            f32x4 a = acc[ai][bj][m][0], b = acc[ai][bj][m][1];
            u32x4 o; o.x = pack2(a[0], a[1]); o.y = pack2(a[2], a[3]); o.z = pack2(b[0], b[1]); o.w = pack2(b[2], b[3]);
            *(u32x4*)(ZA + (rbase + ai * 128 + m * 16) * 2048u + wc * 32 + fq * 8 + bj * 128) = o;
          }
    } else if (pn < 12) {
      const bool isq = pn < 10;
      const float* rope = (const float*)(ws + OFF_ROPE);
      const unsigned cq = (pn & 1) * 256 + cb0;
      u16* dstb;
      unsigned rstride = 512;
      if (isq) dstb = (u16*)(ws + OFF_Q) + (size_t)pm * 256 * 512;
      else if (!sample) dstb = (u16*)(ws + OFF_KP) + (size_t)pm * 256 * 512;
      else dstb = (u16*)(ws + OFF_KS) + ((size_t)((pm - 32) >> 2) * 1280 + 256 + ((pm - 32) & 3) * 256) * 512;
      float* ko = out + OUT_K + (size_t)pm * 256 * 512;
      const int slb = ((pm - 32) & 3) * 256;
#pragma unroll
      for (int ai = 0; ai < 2; ++ai) {
        asm volatile("" ::: "memory");
        float4 csv[4], snv[4];
#pragma unroll
        for (int m = 0; m < 4; ++m) {
          csv[m] = make_float4(1.f, 1.f, 1.f, 1.f); snv[m] = make_float4(0.f, 0.f, 0.f, 0.f);
          if (sample) {
            int sl = slb + rbase + ai * 128 + m * 16;
            int pos = (wc & 1) ? (sl & 63) : (sl >> 6);
            csv[m] = *(const float4*)(rope + pos * 16 + fq * 4);
            snv[m] = *(const float4*)(rope + 1024 + pos * 16 + fq * 4);
          }
        }
#pragma unroll
        for (int m = 0; m < 4; ++m) {
          const unsigned row = rbase + ai * 128 + m * 16;
          const float4 cs = csv[m], sn = snv[m];
#pragma unroll
          for (int bj = 0; bj < 2; ++bj) {
            f32x4 v1 = acc[ai][bj][m][0], v2 = acc[ai][bj][m][1];
            const unsigned off = row * rstride + cq + bj * 128;
            if (!sample && !isq) {
              nt_store4(make_float4(v1[0], v1[1], v1[2], v1[3]), ko + off);
              nt_store4(make_float4(v2[0], v2[1], v2[2], v2[3]), ko + off + 16);
            }
            f32x4 o1, o2;
            o1[0] = v1[0] * cs.x - v2[0] * sn.x; o2[0] = v2[0] * cs.x + v1[0] * sn.x;
            o1[1] = v1[1] * cs.y - v2[1] * sn.y; o2[1] = v2[1] * cs.y + v1[1] * sn.y;
            o1[2] = v1[2] * cs.z - v2[2] * sn.z; o2[2] = v2[2] * cs.z + v1[2] * sn.z;
            o1[3] = v1[3] * cs.w - v2[3] * sn.w; o2[3] = v2[3] * cs.w + v1[3] * sn.w;
            if (isq) { o1 *= 0.18033688011112042f; o2 *= 0.18033688011112042f; }
            u32x2 o1p, o2p;
            o1p.x = pack2(o1[0], o1[1]); o1p.y = pack2(o1[2], o1[3]);
            o2p.x = pack2(o2[0], o2[1]); o2p.y = pack2(o2[2], o2[3]);
            {
              u32x4 oq; oq.x = o1p.x; oq.y = o1p.y; oq.z = o2p.x; oq.w = o2p.y;
              *(u32x4*)(dstb + row * rstride + (pn & 1) * 256 + bj * 128 + wc * 32 + fq * 8) = oq;
            }
          }
        }
      }
    } else if (pn < 14) {
      const unsigned cv0 = (pn & 1) * 256 + wc * 32 + fq * 8;
      float* vo = out + OUT_V + (size_t)pm * 256 * 512;
      u16* vb = sample ? (u16*)(ws + OFF_VTS) + ((size_t)((pm - 32) >> 2) * 1280 + 256 + ((pm - 32) & 3) * 256) * 512
                       : (u16*)(ws + OFF_VTP) + (size_t)pm * 256 * 512;
#pragma unroll
      for (int ai = 0; ai < 2; ++ai)
#pragma unroll
        for (int m = 0; m < 4; ++m)
#pragma unroll
          for (int bj = 0; bj < 2; ++bj) {
            f32x4 a = acc[ai][bj][m][0], b = acc[ai][bj][m][1];
            const unsigned off = (rbase + ai * 128 + m * 16) * 512u + cv0 + bj * 128;
            if (!sample) {
              nt_store4(make_float4(a[0], a[1], a[2], a[3]), vo + off);
              nt_store4(make_float4(b[0], b[1], b[2], b[3]), vo + off + 4);
            }
            u32x4 o; o.x = pack2(a[0], a[1]); o.y = pack2(a[2], a[3]); o.z = pack2(b[0], b[1]); o.w = pack2(b[2], b[3]);
            *(u32x4*)(vb + off) = o;
          }
    } else {
      if (wc == 0) {
        float* GB = (float*)(ws + OFF_GB) + (size_t)pm * 256 * 32;
#pragma unroll
        for (int ai = 0; ai < 2; ++ai)
#pragma unroll
          for (int m = 0; m < 4; ++m)
#pragma unroll
            for (int n = 0; n < 2; ++n) {
              f32x4 a = acc[ai][0][m][n];
              *(float4*)(GB + (rbase + ai * 128 + m * 16) * 32u + n * 16 + fq * 4) = make_float4(a[0], a[1], a[2], a[3]);
            }
      }
    }
  }
};

constexpr int LQS = 0, LKB = 9216, LVB = 18432, LA = 27648, LQK = 44032, LKG = 53248, LST = 62464, LSM = 71680, HSZ = 73216, LW2 = 81920, LU2 = 91136;

DI f32x4 mma16(bf16x8 a, bf16x8 b, f32x4 c) { return __builtin_amdgcn_mfma_f32_16x16x32_bf16(a, b, c, 0, 0, 0); }
DI f32x4 mma_nt64(const char* Aop, const char* Bop, int i0, int j0, int fr, int fq, f32x4 acc) {
#pragma unroll
  for (int ks = 0; ks < 2; ++ks) {
    bf16x8 a = *(const bf16x8*)(Aop + (i0 + fr) * 144 + (ks * 32 + fq * 8) * 2);
    bf16x8 b = *(const bf16x8*)(Bop + (j0 + fr) * 144 + (ks * 32 + fq * 8) * 2);
    acc = mma16(a, b, acc);
  }
  return acc;
}

constexpr int LCW = HSZ;
DI void conv_decode(int item, int& m, int& h, int& L, int& base) {
  if (item < 1024) { const int seq = item >> 5; m = (item >> 3) & 3; h = item & 7; L = 256; base = seq * 256; }
  else { const int i2 = item - 1024; m = (i2 >> 3) & 15; h = i2 & 7; L = 1024; base = T_P + (i2 >> 7) * 1024; }
}
DI void conv_load(const P& p, const u16* ZA, int item, int tid, u32x4 (&zr)[4], float (&cwv)[2]) {
  int m, h, L, base; conv_decode(item, m, h, L, base);
#pragma unroll
  for (int i = 0; i < 4; ++i) {
    int id = tid + 512 * i;
    int row = id / 24, rem = id - row * 24;
    int s = m * 64 - 2 + row;
    u32x4 v = {0u, 0u, 0u, 0u};
    if (id < 1632 && s >= 0 && s < L) v = *(const u32x4*)(ZA + (size_t)(base + s) * 2048 + (rem >> 3) * 512 + h * 64 + (rem & 7) * 8);
    zr[i] = v;
  }
#pragma unroll
  for (int i = 0; i < 2; ++i) {
    int e = tid + 512 * i; cwv[i] = 0.f;
    if (e < 960) { int part = e / 320, r2 = e - part * 320, j = r2 >> 6, d = r2 & 63; cwv[i] = p.conv_w[j * 1536 + part * 512 + h * 64 + d]; }
  }
}
DI void conv_phase(CP pp, int wv) {
  const P p = ldp(pp);
  const u16* ZA = (const u16*)(p.ws + OFF_ZA);
  u16* QK = (u16*)(p.ws + OFF_XN);
  u16* VV = (u16*)(p.ws + OFF_WB1);
  u32x4 zr[4]; float cwv[2];
  if ((int)blockIdx.x < 1536) conv_load(p, ZA, blockIdx.x, ltid(wv), zr, cwv);
  for (int item = blockIdx.x; item < 1536; item += gridDim.x) {
    int m, h, L, base; conv_decode(item, m, h, L, base);
    const int tid = ltid(wv), lw = tid >> 6, lane = tid & 63;
    __syncthreads();
#pragma unroll
    for (int i = 0; i < 4; ++i) { int id = tid + 512 * i; if (id < 1632) *(u32x4*)(dsm + id * 16) = zr[i]; }
#pragma unroll
    for (int i = 0; i < 2; ++i) { int e = tid + 512 * i; if (e < 960) ((float*)(dsm + 26624))[e] = cwv[i]; }
    __syncthreads();
    if (item + (int)gridDim.x < 1536) conv_load(p, ZA, item + gridDim.x, tid, zr, cwv);
    {
      const int d = lane, so = lw * 8;
      const float* cwl = (const float*)(dsm + 26624);
#pragma unroll
      for (int part = 0; part < 3; ++part) {
        float cw[5];
#pragma unroll
        for (int j = 0; j < 5; ++j) cw[j] = cwl[part * 320 + j * 64 + d];
        float zv[12];
#pragma unroll
        for (int i = 0; i < 12; ++i) zv[i] = bf2f(*(const u16*)(dsm + (so + i) * 384 + part * 128 + d * 2));
#pragma unroll
        for (int i = 0; i < 8; ++i) {
          float v = cw[0] * zv[i] + cw[1] * zv[i + 1] + cw[2] * zv[i + 2] + cw[3] * zv[i + 3] + cw[4] * zv[i + 4];
          v = siluf(v);
          if (part < 2) {
            float ss = wave_sum(v * v);
            v *= rsqrtf(ss + 1e-6f);
            if (part == 0) v *= 0.125f;
          }
          const size_t t = (size_t)(base + m * 64 + so + i);
          if (part < 2) QK[((t * 8 + h) * 2 + part) * 64 + d] = f2bf(v);
          else VV[(t * 8 + h) * 64 + d] = f2bf(v);
        }
      }
    }
  }
  __syncthreads();
}
DI void dn_prefetch(const u16* QK, const u16* VV, const float* GB, int base, int mch, int hf, int h, int tid, u32x4 (&zr)[3], float& gad, float& gab) {
  const int r = (tid & 511) >> 3, cp = tid & 7;
  const size_t t = (size_t)(base + mch * 64 + r);
  zr[0] = *(const u32x4*)(QK + ((t * 8 + h) * 2 + 0) * 64 + cp * 8);
  zr[1] = *(const u32x4*)(QK + ((t * 8 + h) * 2 + 1) * 64 + cp * 8);
  zr[2] = *(const u32x4*)(VV + (t * 8 + h) * 64 + cp * 8);
  if (tid < 64) {
    int tk = base + mch * 64 + (hf ? 63 - tid : tid);
    gad = GB[(size_t)tk * 32 + hf * 8 + h];
    gab = GB[(size_t)tk * 32 + 16 + hf * 8 + h];
  }
}

DI void deltanet_item(const P& p, int item, int wv) {
  const int seq = item >> 4, h = (item >> 1) & 7, hf = item & 1;
  const bool sample = seq >= 32;
  const int L = sample ? 1024 : 256, N = L >> 6;
  const int base = sample ? T_P + (seq - 32) * 1024 : seq * 256;
  const u16* QK = (const u16*)(p.ws + OFF_XN);
  const u16* VV = (const u16*)(p.ws + OFF_WB1);
  const float* GB = (const float*)(p.ws + OFF_GB);
  char* hb = dsm;
  float* sm = (float*)(hb + LSM);
  u16* OB = (u16*)(p.ws + OFF_HID) + (size_t)hf * T_TOK * 512;
  const float alog = -expf(p.a_log[hf * 8 + h]);
  const float dtb = p.dt_bias[hf * 8 + h];

  f32x4 sacc[2];
  u32x4 zr[3]; float gad = 0.f, gab = 0.f;
  {
    const int tid = ltid(wv), lw = tid >> 6, lane = tid & 63, fr = lane & 15, fq = lane >> 4;
#pragma unroll
    for (int k = 0; k < 2; ++k) {
      const int dt = 2 * (lw >> 2) + k, et = lw & 3;
      if (sample) {
        const float* s0 = p.state + (((size_t)(seq - 32) * 2 + hf) * 8 + h) * 4096;
#pragma unroll
        for (int r = 0; r < 4; ++r) sacc[k][r] = s0[(dt * 16 + fq * 4 + r) * 64 + et * 16 + fr];
      } else {
        sacc[k] = f32x4{0.f, 0.f, 0.f, 0.f};
      }
      u32x2 o; o.x = pack2(sacc[k][0], sacc[k][1]); o.y = pack2(sacc[k][2], sacc[k][3]);
      *(u32x2*)(hb + LST + (et * 16 + fr) * 144 + (dt * 16 + fq * 4) * 2) = o;
    }
    dn_prefetch(QK, VV, GB, base, hf ? N - 1 : 0, hf, h, tid, zr, gad, gab);
  }

  for (int n = 0; n < N; ++n) {
    const int tid = ltid(wv);
    const int lw = tid >> 6, lane = tid & 63, fr = lane & 15, fq = lane >> 4;
    const int wq = lw & 3, wh = lw >> 2;
    const int mch = hf ? N - 1 - n : n;
    {
      const int r = tid >> 3, cp = tid & 7, c = hf ? 63 - r : r;
      *(u32x4*)(hb + LQS + c * 144 + cp * 16) = zr[0];
      *(u32x4*)(hb + LKB + c * 144 + cp * 16) = zr[1];
      *(u32x4*)(hb + LVB + c * 144 + cp * 16) = zr[2];
    }
    if (lw == 0) {
      const int c = lane;
      const float ad = gad + dtb;
      float sp = ad > 20.f ? ad : log1pf(expf(ad));
      float g = alog * sp;
      float bt = 1.f / (1.f + expf(-gab));
      float gc = g;
#pragma unroll
      for (int o = 1; o < 64; o <<= 1) { float v = __shfl_up(gc, o); if (lane >= o) gc += v; }
      float gl = __shfl(gc, 63);
      const float egc_ = expf(gc);
      sm[c] = gc; sm[64 + c] = bt; sm[128 + c] = egc_; sm[192 + c] = expf(gl - gc); sm[256 + c] = bt; sm[320 + c] = bt * egc_;
    }
    __syncthreads();
    {
#pragma unroll
      for (int k = 0; k < 2; ++k) {
        const int jt = 2 * wh + k;
        f32x4 dk = mma_nt64(hb + LKB, hb + LKB, wq * 16, jt * 16, fr, fq, f32x4{0.f, 0.f, 0.f, 0.f});
        int s = jt * 16 + fr;
        float gs = sm[s];
#pragma unroll
        for (int r = 0; r < 4; ++r) {
          int c = wq * 16 + fq * 4 + r;
          float v = s < c ? sm[64 + c] * dk[r] * __expf(sm[c] - gs) : 0.f;
          *(float*)(hb + LA + (s * 64 + (c & 3) * 16 + (c >> 2)) * 4) = v;
        }
      }
#pragma unroll
      for (int k = 0; k < 2; ++k) {
        const int it = 2 * wh + k;
        f32x4 dq = mma_nt64(hb + LKB, hb + LQS, it * 16, wq * 16, fr, fq, f32x4{0.f, 0.f, 0.f, 0.f});
        int c = wq * 16 + fr;
        float gcc = sm[c];
        float v[4];
#pragma unroll
        for (int r = 0; r < 4; ++r) {
          int s = it * 16 + fq * 4 + r;
          v[r] = s <= c ? dq[r] * __expf(gcc - sm[s]) : 0.f;
        }
        u32x2 o; o.x = pack2(v[0], v[1]); o.y = pack2(v[2], v[3]);
        *(u32x2*)(hb + LQK + c * 144 + (it * 16 + fq * 4) * 2) = o;
      }
    }
    __syncthreads();
    if (n + 1 < N) dn_prefetch(QK, VV, GB, base, hf ? N - 2 - n : n + 1, hf, h, tid, zr, gad, gab);
    {
      const int d = lane;
#pragma unroll
      for (int i = 0; i < 8; i += 2) {
        int c = lw * 8 + i;
        float k0 = bf2f(*(const u16*)(hb + LKB + c * 144 + d * 2)) * sm[192 + c];
        float k1 = bf2f(*(const u16*)(hb + LKB + (c + 1) * 144 + d * 2)) * sm[192 + c + 1];
        *(unsigned*)(hb + LKG + d * 144 + c * 2) = pack2(k0, k1);
      }
    }
    float xp[16];
    const int sj = tid >> 2, par = tid & 3;
    {
      const float* ATb = (const float*)(hb + LA) + par * 16;
      const char* rsrc = (sj < 64) ? hb + LVB + sj * 2 : hb + LKB + (sj - 64) * 2;
      const float* rs = sm + (sj < 64 ? 256 : 320);
#pragma unroll
      for (int i = 0; i < 16; ++i) xp[i] = rs[4 * i + par] * bf2f(*(const u16*)(rsrc + (4 * i + par) * 144));
#define DN_LOADA(dst, s_) _Pragma("unroll") for (int q = (((s_) >> 2) >> 2); q < 4; ++q) dst[q] = *(const float4*)(ATb + (s_) * 64 + q * 4)
#define DN_STEP(s_, Aq) do { const float xs_ = quad_bcast(xp[(s_) >> 2], (s_)); const f32x2 xs2_ = {xs_, xs_}; \
        _Pragma("unroll") for (int q = (((s_) >> 2) >> 2); q < 4; ++q) { \
          f32x2 lo_ = {xp[4 * q], xp[4 * q + 1]}, hi_ = {xp[4 * q + 2], xp[4 * q + 3]}; \
          const f32x2 al_ = {Aq[q].x, Aq[q].y}, ah_ = {Aq[q].z, Aq[q].w}; \
          lo_ = __builtin_elementwise_fma(-al_, xs2_, lo_); hi_ = __builtin_elementwise_fma(-ah_, xs2_, hi_); \
          xp[4 * q] = lo_[0]; xp[4 * q + 1] = lo_[1]; xp[4 * q + 2] = hi_[0]; xp[4 * q + 3] = hi_[1]; } } while (0)
      float4 A0[4], A1[4], A2[4], A3[4];
      DN_LOADA(A0, 0); DN_LOADA(A1, 1);
#pragma unroll
      for (int s = 0; s < 60; s += 4) {
        DN_LOADA(A2, s + 2); DN_LOADA(A3, s + 3); __builtin_amdgcn_sched_barrier(0);
        DN_STEP(s, A0); DN_STEP(s + 1, A1); __builtin_amdgcn_sched_barrier(0);
        DN_LOADA(A0, s + 4); DN_LOADA(A1, s + 5); __builtin_amdgcn_sched_barrier(0);
        DN_STEP(s + 2, A2); DN_STEP(s + 3, A3); __builtin_amdgcn_sched_barrier(0);
      }
      DN_LOADA(A2, 62); __builtin_amdgcn_sched_barrier(0);
      DN_STEP(60, A0); DN_STEP(61, A1); DN_STEP(62, A2);
    }
    if (sj < 64) {
#pragma unroll
      for (int i = 0; i < 16; ++i) *(u16*)(hb + LU2 + sj * 144 + (4 * i + par) * 2) = f2bf(xp[i]);
    } else {
#pragma unroll
      for (int i = 0; i < 16; ++i) *(u16*)(hb + LW2 + (4 * i + par) * 144 + (sj - 64) * 2) = f2bf(xp[i]);
    }
    __syncthreads();
    {
#pragma unroll
      for (int k = 0; k < 2; ++k) {
        const int ct = 2 * wh + k;
        f32x4 dd = mma_nt64(hb + LW2, hb + LST, ct * 16, wq * 16, fr, fq, f32x4{0.f, 0.f, 0.f, 0.f});
        int e = wq * 16 + fr;
        u32x2 u0 = *(const u32x2*)(hb + LU2 + e * 144 + (ct * 16 + fq * 4) * 2);
        float v0 = __uint_as_float(u0.x << 16) - dd[0], v1 = __uint_as_float(u0.x & 0xffff0000u) - dd[1];
        float v2 = __uint_as_float(u0.y << 16) - dd[2], v3 = __uint_as_float(u0.y & 0xffff0000u) - dd[3];
        u32x2 o; o.x = pack2(v0, v1); o.y = pack2(v2, v3);
        *(u32x2*)(hb + LA + e * 144 + (ct * 16 + fq * 4) * 2) = o;
      }
    }
    __syncthreads();
    {
      const int c = wq * 16 + fr;
      const float egc = sm[128 + c];
      const int tk = base + mch * 64 + (hf ? 63 - c : c);
#pragma unroll
      for (int k = 0; k < 2; ++k) {
        const int et = 2 * wh + k;
        f32x4 o = mma_nt64(hb + LST, hb + LQS, et * 16, wq * 16, fr, fq, f32x4{0.f, 0.f, 0.f, 0.f});
        o *= egc;
        o = mma_nt64(hb + LA, hb + LQK, et * 16, wq * 16, fr, fq, o);
        { u32x2 ov; ov.x = pack2(o[0], o[1]); ov.y = pack2(o[2], o[3]); *(u32x2*)(OB + (size_t)tk * 512 + h * 64 + et * 16 + fq * 4) = ov; }
      }
      const float egl = sm[128 + 63];
#pragma unroll
      for (int k = 0; k < 2; ++k) {
        const int dt = 2 * wh + k;
        sacc[k] *= egl;
        sacc[k] = mma_nt64(hb + LKG, hb + LA, dt * 16, wq * 16, fr, fq, sacc[k]);
      }
    }
    __syncthreads();
#pragma unroll
    for (int k = 0; k < 2; ++k) {
      const int dt = 2 * wh + k;
      u32x2 o; o.x = pack2(sacc[k][0], sacc[k][1]); o.y = pack2(sacc[k][2], sacc[k][3]);
      *(u32x2*)(hb + LST + (wq * 16 + fr) * 144 + (dt * 16 + fq * 4) * 2) = o;
    }
  }
  if (!sample) {
    const int tid = ltid(wv), lw = tid >> 6, lane = tid & 63, fr = lane & 15, fq = lane >> 4;
    float* so = p.out + OUT_S + (((size_t)seq * 2 + hf) * 8 + h) * 4096;
#pragma unroll
    for (int k = 0; k < 2; ++k)
#pragma unroll
      for (int r = 0; r < 4; ++r) so[((2 * (lw >> 2) + k) * 16 + fq * 4 + r) * 64 + (lw & 3) * 16 + fr] = sacc[k][r];
  }
  __syncthreads();
}

DI f32x16 mma32(bf16x8 a, bf16x8 b, f32x16 c) { return __builtin_amdgcn_mfma_f32_32x32x16_bf16(a, b, c, 0, 0, 0); }

DI void attn_item(const P& p, int item, int wv) {
  const int tid = ltid(wv), wid = tid >> 6, lane = tid & 63, r = lane & 31, h = lane >> 5;
  int b, head, qb, nk, tokbase;
  const u16* Kg; const u16* Vg;
  if (item < 64) {
    b = item >> 4; head = (item >> 2) & 3; qb = item & 3; nk = 1280; tokbase = T_P + b * 1024 + qb * 256;
    Kg = (const u16*)(p.ws + OFF_KS) + (size_t)b * 1280 * 512 + head * 128;
    Vg = (const u16*)(p.ws + OFF_VTS) + (size_t)b * 1280 * 512 + head * 128;
  } else {
    int id = item - 64; b = id >> 2; head = id & 3; qb = 0; nk = 256; tokbase = b * 256;
    Kg = (const u16*)(p.ws + OFF_KP) + (size_t)b * 256 * 512 + head * 128;
    Vg = (const u16*)(p.ws + OFF_VTP) + (size_t)b * 256 * 512 + head * 128;
  }
  float s1 = wave_sum(p.lq1[lane] * p.lk1[lane]);
  float s2 = wave_sum(p.lq2[lane] * p.lk2[lane]);
  const float lam = expf(s1) - expf(s2) + 0.2f;
  const int tq = tokbase + wid * 32 + r;
  const u16* Qg = (const u16*)(p.ws + OFF_Q) + (size_t)tq * 512 + head * 128;
  bf16x8 q[2][4];
#pragma unroll
  for (int mp = 0; mp < 2; ++mp)
#pragma unroll
    for (int ks = 0; ks < 4; ++ks) q[mp][ks] = *(const bf16x8*)(Qg + mp * 64 + ks * 16 + 8 * h);
  const int ntile = nk >> 6;
  float m0 = -1e30f, m1 = -1e30f, l0 = 0.f, l1 = 0.f;
  u32x4 kr[2], vr[2] = {};
  {
#pragma unroll
    for (int i = 0; i < 2; ++i) { int id = tid + 512 * i; int row = id >> 4, cp = id & 15;
      kr[i] = *(const u32x4*)(Kg + (size_t)row * 512 + cp * 8); }
  }
  __syncthreads();
  for (int t = 0; t < ntile; ++t) {
    char* KT = dsm + (t & 1) * 36864;
#pragma unroll
    for (int i = 0; i < 2; ++i) { int id = tid + 512 * i; int row = id >> 4, cp = id & 15;
      *(u32x4*)(KT + row * 272 + cp * 16) = kr[i]; }
    __syncthreads();
    if (t + 1 < ntile) {
#pragma unroll
      for (int i = 0; i < 2; ++i) { int id = tid + 512 * i; int row = id >> 4, cp = id & 15;
        kr[i] = *(const u32x4*)(Kg + (size_t)((t + 1) * 64 + row) * 512 + cp * 8); }
    } else {
#pragma unroll
      for (int i = 0; i < 2; ++i) { int id = tid + 512 * i; int row = id >> 4, cp = id & 15;
        kr[i] = *(const u32x4*)(Kg + (size_t)row * 512 + cp * 8);
        int vkey = id & 63, vcp = id >> 6;
        vr[i] = *(const u32x4*)(Vg + (size_t)vkey * 512 + vcp * 8); }
    }
#pragma unroll
    for (int kb2 = 0; kb2 < 2; ++kb2) {
      f32x16 sa = {}, sb = {};
#pragma unroll
      for (int ks = 0; ks < 4; ++ks) {
        bf16x8 a0 = *(const bf16x8*)(KT + (kb2 * 32 + r) * 272 + (ks * 16 + 8 * h) * 2);
        bf16x8 a1 = *(const bf16x8*)(KT + (kb2 * 32 + r) * 272 + (64 + ks * 16 + 8 * h) * 2);
        sa = mma32(a0, q[0][ks], sa); sb = mma32(a1, q[1][ks], sb);
      }
      float mx0 = sa[0], mx1 = sb[0];
#pragma unroll
      for (int i = 1; i < 16; ++i) { mx0 = fmaxf(mx0, sa[i]); mx1 = fmaxf(mx1, sb[i]); }
      float n0 = fmaxf(m0, mx0), n1 = fmaxf(m1, mx1);
      f32x2 acc0 = {0.f, 0.f}, acc1 = {0.f, 0.f};
      const f32x2 nn0 = {n0, n0}, nn1 = {n1, n1};
#pragma unroll
      for (int i = 0; i < 16; i += 2) {
        f32x2 d0 = f32x2{sa[i], sa[i + 1]} - nn0, d1 = f32x2{sb[i], sb[i + 1]} - nn1;
        acc0 += f32x2{__builtin_amdgcn_exp2f(d0[0]), __builtin_amdgcn_exp2f(d0[1])};
        acc1 += f32x2{__builtin_amdgcn_exp2f(d1[0]), __builtin_amdgcn_exp2f(d1[1])};
      }
      const float a0 = acc0[0] + acc0[1], a1 = acc1[0] + acc1[1];
      l0 = l0 * __builtin_amdgcn_exp2f(m0 - n0) + a0; l1 = l1 * __builtin_amdgcn_exp2f(m1 - n1) + a1;
      m0 = n0; m1 = n1;
    }
  }
  {
    float mo0 = __shfl_xor(m0, 32), lo0 = __shfl_xor(l0, 32), mo1 = __shfl_xor(m1, 32), lo1 = __shfl_xor(l1, 32);
    float M0 = fmaxf(m0, mo0), M1 = fmaxf(m1, mo1);
    l0 = l0 * __builtin_amdgcn_exp2f(m0 - M0) + lo0 * __builtin_amdgcn_exp2f(mo0 - M0);
    l1 = l1 * __builtin_amdgcn_exp2f(m1 - M1) + lo1 * __builtin_amdgcn_exp2f(mo1 - M1);
    m0 = M0; m1 = M1;
  }
  const float f0 = m0 + __log2f(l0);
  const float f1 = m1 + __log2f(l1) - __log2f(fmaxf(fabsf(lam), 1e-30f));
  const float sg = lam < 0.f ? -1.f : 1.f;
  f32x16 oacc[4] = {};
  __syncthreads();
  for (int t = 0; t < ntile; ++t) {
    char* KT = dsm + (t & 1) * 36864;
    char* VT = KT + 17408;
#pragma unroll
    for (int i = 0; i < 2; ++i) { int id = tid + 512 * i; int row = id >> 4, cp = id & 15;
      *(u32x4*)(KT + row * 272 + cp * 16) = kr[i];
      int vkey = id & 63, vcp = id >> 6;
      const unsigned vw[4] = {vr[i].x, vr[i].y, vr[i].z, vr[i].w};
#pragma unroll
      for (int j = 0; j < 4; ++j) {
        *(u16*)(VT + (vcp * 8 + 2 * j) * 144 + vkey * 2) = (u16)(vw[j] & 0xffffu);
        *(u16*)(VT + (vcp * 8 + 2 * j + 1) * 144 + vkey * 2) = (u16)(vw[j] >> 16);
      } }
    __syncthreads();
    if (t + 1 < ntile) {
#pragma unroll
      for (int i = 0; i < 2; ++i) { int id = tid + 512 * i; int row = id >> 4, cp = id & 15;
        kr[i] = *(const u32x4*)(Kg + (size_t)((t + 1) * 64 + row) * 512 + cp * 8);
        int vkey = id & 63, vcp = id >> 6;
        vr[i] = *(const u32x4*)(Vg + (size_t)((t + 1) * 64 + vkey) * 512 + vcp * 8); }
    }
#pragma unroll
    for (int kb2 = 0; kb2 < 2; ++kb2) {
      f32x16 sa = {}, sb = {};
#pragma unroll
      for (int ks = 0; ks < 4; ++ks) {
        bf16x8 a0 = *(const bf16x8*)(KT + (kb2 * 32 + r) * 272 + (ks * 16 + 8 * h) * 2);
        bf16x8 a1 = *(const bf16x8*)(KT + (kb2 * 32 + r) * 272 + (64 + ks * 16 + 8 * h) * 2);
        sa = mma32(a0, q[0][ks], sa); sb = mma32(a1, q[1][ks], sb);
      }
      float av[16];
      {
        const f32x2 ff0 = {f0, f0}, ff1 = {f1, f1}, nsg = {-sg, -sg};
#pragma unroll
        for (int i = 0; i < 16; i += 2) {
          f32x2 d0 = f32x2{sa[i], sa[i + 1]} - ff0, d1 = f32x2{sb[i], sb[i + 1]} - ff1;
          f32x2 e0 = {__builtin_amdgcn_exp2f(d0[0]), __builtin_amdgcn_exp2f(d0[1])};
          f32x2 e1 = {__builtin_amdgcn_exp2f(d1[0]), __builtin_amdgcn_exp2f(d1[1])};
          f32x2 r = __builtin_elementwise_fma(nsg, e1, e0);
          av[i] = r[0]; av[i + 1] = r[1];
        }
      }
#pragma unroll
      for (int s = 0; s < 2; ++s) {
        u32x4 pp;
        pp.x = pack2(av[8 * s], av[8 * s + 1]); pp.y = pack2(av[8 * s + 2], av[8 * s + 3]);
        pp.z = pack2(av[8 * s + 4], av[8 * s + 5]); pp.w = pack2(av[8 * s + 6], av[8 * s + 7]);
        bf16x8 pb = __builtin_bit_cast(bf16x8, pp);
#pragma unroll
        for (int dvb = 0; dvb < 4; ++dvb) {
          const char* vp = VT + (dvb * 32 + r) * 144 + (kb2 * 32 + 16 * s + 4 * h) * 2;
          u32x2 lo = *(const u32x2*)(vp), hi = *(const u32x2*)(vp + 16);
          u32x4 vv; vv.x = lo.x; vv.y = lo.y; vv.z = hi.x; vv.w = hi.y;
          oacc[dvb] = mma32(__builtin_bit_cast(bf16x8, vv), pb, oacc[dvb]);
        }
      }
    }
  }
  float ss = 0.f;
#pragma unroll
  for (int dvb = 0; dvb < 4; ++dvb)
#pragma unroll
    for (int i = 0; i < 16; ++i) ss += oacc[dvb][i] * oacc[dvb][i];
  ss += __shfl_xor(ss, 32);
  const float rstd = rsqrtf(ss * (1.f / 128.f) + 1e-6f) * 0.8f;
  u16* MIX = (u16*)(p.ws + OFF_MIX) + (size_t)tq * 1024 + 512 + head * 128;
#pragma unroll
  for (int dvb = 0; dvb < 4; ++dvb)
#pragma unroll
    for (int g = 0; g < 4; ++g) {
      int dv = dvb * 32 + 8 * g + 4 * h;
      float4 dn = *(const float4*)(p.diff_norm + dv);
      u32x2 o;
      o.x = pack2(oacc[dvb][4 * g] * rstd * dn.x, oacc[dvb][4 * g + 1] * rstd * dn.y);
      o.y = pack2(oacc[dvb][4 * g + 2] * rstd * dn.z, oacc[dvb][4 * g + 3] * rstd * dn.w);
      *(u32x2*)(MIX + dv) = o;
    }
  __syncthreads();
}

DI void mixer_phase(CP pp, int wv, int rep) {
  const P p = ldp(pp);
  int* ctr = (int*)(p.ws + OFF_CTR) + rep;
  int* cur = (int*)(dsm + LDS_BYTES - 16);
  while (true) {
    __syncthreads();
    if (ltid(wv) == 0) *cur = atomicAdd(ctr, 1);
    __syncthreads();
    int it = *cur;
    __syncthreads();
    if (it >= 768 + 592) break;
    if (it >= 768) {
      const int id = it - 768;
      if (id < 64) transpose_tile(p.w_out, 1024, (u16*)(p.ws + OFF_WB4), 1024, (id % 4) * 256, (id / 4) * 64, 0, wv);
      else if (id < 64 + 352) { const int j = id - 64; transpose_tile(p.w_ffn2_in, 5632, (u16*)(p.ws + OFF_WB5), 1024, (j % 22) * 256, (j / 22) * 64, 1, wv); }
      else { const int j = id - 416; transpose_tile(p.w_ffn2_out, 1024, (u16*)(p.ws + OFF_WB6), DFF, (j % 4) * 256, (j / 4) * 64, 0, wv); }
      continue;
    }
    if (it < 64) { for (int r2 = 0; r2 < DN_REP; ++r2) deltanet_item(p, 512 + it, wv); }
    else if (it < 128) { for (int r2 = 0; r2 < AT_REP; ++r2) attn_item(p, it - 64, wv); }
    else if (it < 640) { for (int r2 = 0; r2 < DN_REP; ++r2) deltanet_item(p, it - 128, wv); }
    else { for (int r2 = 0; r2 < AT_REP; ++r2) attn_item(p, it - 640 + 64, wv); }
  }
}

DI void combine_phase(CP pp, int wv) {
  const P p = ldp(pp);
  const int tidc = ltid(wv), lane = tidc & 63, wid = tidc >> 6;
  const u16* OB = (const u16*)(p.ws + OFF_HID);
  const u16* ZA = (const u16*)(p.ws + OFF_ZA);
  u16* MIX = (u16*)(p.ws + OFF_MIX);
  const int e0 = (lane & 7) * 8;
  const float4 dn0 = *(const float4*)(p.delta_norm + e0), dn1 = *(const float4*)(p.delta_norm + e0 + 4);
  for (int w = blockIdx.x * 8 + wid; w < 2048; w += gridDim.x * 8)
  for (int half = 0; half < 1; ++half) {
    u32x4 a[6][2]; u32x4 z[6];
#pragma unroll
    for (int rr = 0; rr < 6; ++rr) {
      const int t = w * 6 + rr;
      const size_t idx = (size_t)t * 512 + lane * 8;
      a[rr][0] = *(const u32x4*)(OB + idx);
      a[rr][1] = *(const u32x4*)(OB + (size_t)T_TOK * 512 + idx);
      z[rr] = *(const u32x4*)(ZA + (size_t)t * 2048 + 1536 + lane * 8);
    }
#pragma unroll
    for (int rr = 0; rr < 6; ++rr) {
      const int t = w * 6 + rr;
      float o[8];
      {
        const unsigned fa[4] = {a[rr][0].x, a[rr][0].y, a[rr][0].z, a[rr][0].w}, fb[4] = {a[rr][1].x, a[rr][1].y, a[rr][1].z, a[rr][1].w};
#pragma unroll
        for (int i = 0; i < 4; ++i) {
          o[2 * i] = __uint_as_float(fa[i] << 16) + __uint_as_float(fb[i] << 16);
          o[2 * i + 1] = __uint_as_float(fa[i] & 0xffff0000u) + __uint_as_float(fb[i] & 0xffff0000u);
        }
      }
      float ss = 0.f;
#pragma unroll
      for (int i = 0; i < 8; ++i) ss += o[i] * o[i];
      ss = oct_sum(ss);
      const float rstd = rsqrtf(ss * (1.f / 64.f) + 1e-6f);
      const float dnv[8] = {dn0.x, dn0.y, dn0.z, dn0.w, dn1.x, dn1.y, dn1.z, dn1.w};
      const unsigned zz[4] = {z[rr].x, z[rr].y, z[rr].z, z[rr].w};
      float y[8];
#pragma unroll
      for (int i = 0; i < 8; ++i) {
        float zv = (i & 1) ? __uint_as_float(zz[i >> 1] & 0xffff0000u) : __uint_as_float(zz[i >> 1] << 16);
        y[i] = o[i] * rstd * dnv[i] * siluf(zv);
      }
      u32x4 r; r.x = pack2(y[0], y[1]); r.y = pack2(y[2], y[3]); r.z = pack2(y[4], y[5]); r.w = pack2(y[6], y[7]);
      *(u32x4*)(MIX + (size_t)t * 1024 + lane * 8) = r;
    }
  }
}

DI void deferred_w23(CP pp, int wv) {
  const P p = ldp(pp);
  const int ntiles = 48 * 22, rem = ntiles % (int)gridDim.x;
  int first, stride;
  if (rem == 0) { first = blockIdx.x; stride = gridDim.x; }
  else { if ((int)blockIdx.x < rem) return; first = blockIdx.x - rem; stride = gridDim.x - rem; }
  for (int id = first; id < 176 + 240; id += stride) {
    if (id < 176) transpose_tile(p.w_ffn1_out, 1024, (u16*)(p.ws + OFF_WB2), DFF, (id % 4) * 256, (id / 4) * 64, 0, wv);
    else { const int j = id - 176; transpose_tile(p.w_in, 3616, (u16*)(p.ws + OFF_WB3), 1024, (j % 15) * 256, (j / 15) * 64, 2, wv); }
  }
  phase0(pp, wv, first, stride);
}

DI void gemm_dispatch(CP pp, int wv, int which) {
  const P p = ldp(pp);
  const u16* XN = (const u16*)(p.ws + OFF_XN);
  u16* HID = (u16*)(p.ws + OFF_HID);
  const float* MOD = (const float*)(p.ws + OFF_MOD);
  float* Y = p.out + OUT_Y;
  switch (which) {
    case 2: gemm_phase<4>(XN, (const u16*)(p.ws + OFF_WB1), 1024, 48, 22, EpiSwiGLU{HID}, wv); break;
    case 3: gemm_phase<3>(HID, (const u16*)(p.ws + OFF_WB2), DFF, 64, 4, EpiResid192{p.x_prompt, p.x_sample, Y, MOD, 2, 0.5f}, wv); break;
    case 5: gemm_phase<4>(XN, (const u16*)(p.ws + OFF_WB3), 1024, 48, 15, EpiInProj{p.ws, p.out}, wv); break;
    case 8: gemm_phase<3>((const u16*)(p.ws + OFF_MIX), (const u16*)(p.ws + OFF_WB4), 1024, 64, 4, EpiResid192{Y, Y + (size_t)T_P * 1024, Y, MOD, 5, 1.0f}, wv); break;
    case 10: gemm_phase<4>(XN, (const u16*)(p.ws + OFF_WB5), 1024, 48, 22, EpiSwiGLU{HID}, wv); break;
    case 11: gemm_phase<3>(HID, (const u16*)(p.ws + OFF_WB6), DFF, 64, 4, EpiResid192{Y, Y + (size_t)T_P * 1024, Y, MOD, 8, 0.5f}, wv); break;
  }
}

__global__ void __launch_bounds__(512, 2) mega(P pv) {
  cg::grid_group grid = cg::this_grid();
  CP pp = (CP)__builtin_amdgcn_kernarg_segment_ptr();
  const int wv = __builtin_amdgcn_readfirstlane(threadIdx.x >> 6);
  const int plo = pp->plo, phi = pp->phi;
  if (phi > 1000) grid.sync();
  gbar_post(pp, wv);
#ifdef EXTRA_SYNCS
  for (int i = 0; i < EXTRA_SYNCS; ++i) gbar(pp, wv);
#endif
  for (int ph = plo; ph <= phi; ++ph) {
    const int reps = ((REPEAT_MASK >> ph) & 1) ? 2 : 1;
    for (int rep = 0; rep < reps; ++rep) {
    if (ph > plo || rep > 0) gbar(pp, wv);
    switch (ph) {
      case 0: phase0(pp, wv); break;
      case 1: norm_phase<0>(pp, wv); break;
      case 4: norm_phase<1>(pp, wv); break;
      case 6: conv_phase(pp, wv); gbar(pp, wv); mixer_phase(pp, wv, rep); break;
      case 7: combine_phase(pp, wv); break;
      case 9: norm_phase<2>(pp, wv); break;
      case 12: norm_phase<3>(pp, wv); break;
      default: gemm_dispatch(pp, wv, ph); if (ph == 2 && rep == 0) deferred_w23(pp, wv); break;
    }
    }
  }
}

extern "C" void kernel_launch(void* const* d_in, const int* in_sizes, int n_in, void* d_out, int out_size,
                              void* d_ws, size_t ws_size, hipStream_t stream) {
  static int grid_blocks = 0;
  if (!grid_blocks) {
    int dev = 0, cus = 0, per_cu = 0;
    hipGetDevice(&dev);
    hipDeviceGetAttribute(&cus, hipDeviceAttributeMultiprocessorCount, dev);
    hipFuncSetAttribute((const void*)mega, hipFuncAttributeMaxDynamicSharedMemorySize, LDS_BYTES);
    hipOccupancyMaxActiveBlocksPerMultiprocessor(&per_cu, (const void*)mega, 512, LDS_BYTES);
    if (per_cu < 1) per_cu = 1;
    grid_blocks = cus * per_cu;
    if (grid_blocks > 256) grid_blocks = 256;
    grid_blocks &= ~7;
    if (ws_size < WS_END) fprintf(stderr, "workspace too small: %zu < %zu\n", ws_size, (size_t)WS_END);
  }
  hipMemsetAsync((char*)d_ws + OFF_BAR, 0, 16384, stream);
  P p{};
  const float** f = (const float**)&p;
  for (int i = 0; i < 28; ++i) f[i] = (const float*)d_in[i];
  p.out = (float*)d_out; p.ws = (char*)d_ws;
#if MK_MULTI
  for (int ph = 0; ph <= 12; ++ph) {
    p.plo = ph; p.phi = ph;
    hipLaunchKernelGGL(mega, dim3(grid_blocks), dim3(512), LDS_BYTES, stream, p);
  }
#else
  p.plo = 0; p.phi = 12;
  void* args[] = {&p};
  hipError_t e = hipLaunchCooperativeKernel((const void*)mega, dim3(grid_blocks), dim3(512), args, LDS_BYTES, stream);
  if (e != hipSuccess) fprintf(stderr, "cooperative launch failed: %s (grid %d)\n", hipGetErrorString(e), grid_blocks);
#endif
}
```

```cpp
#include <hip/hip_runtime.h>
#include <hip/hip_cooperative_groups.h>
#include <cstdio>
namespace cg = cooperative_groups;

#ifndef DN_REP
#define DN_REP 1
#endif
#ifndef AT_REP
#define AT_REP 1
#endif
#ifndef REPEAT_MASK
#define REPEAT_MASK 0
#endif
#ifndef MK_MULTI
#define MK_MULTI 0
#endif

#define DI __device__ __forceinline__
typedef unsigned short u16;
using bf16x8 = __attribute__((ext_vector_type(8))) short;
using s16x4  = __attribute__((ext_vector_type(4))) short;
using f32x4  = __attribute__((ext_vector_type(4))) float;
using f32x2  = __attribute__((ext_vector_type(2))) float;
using f32x16 = __attribute__((ext_vector_type(16))) float;
using u32x2  = __attribute__((ext_vector_type(2))) unsigned;
using u32x4  = __attribute__((ext_vector_type(4))) unsigned;

extern __shared__ __attribute__((aligned(16))) char dsm[];

constexpr int T_TOK = 12288, T_P = 8192, DM = 1024, DFF = 2816;
constexpr int NKS = 16;
constexpr int LDS_BYTES = 131072 + 64;

constexpr size_t OFF_WB1 = 0;
constexpr size_t OFF_WB2 = OFF_WB1 + 11534336;
constexpr size_t OFF_WB3 = OFF_WB2 + 5767168;
constexpr size_t OFF_WB4 = OFF_WB3 + 7864320;
constexpr size_t OFF_WB5 = OFF_WB4 + 2097152;
constexpr size_t OFF_WB6 = OFF_WB5 + 11534336;
constexpr size_t OFF_MODP = OFF_WB6 + 5767168;
constexpr size_t OFF_MOD = OFF_MODP + (size_t)NKS * 5 * 9216 * 4;
constexpr size_t OFF_ROPE = OFF_MOD + 5 * 9216 * 4;
constexpr size_t OFF_CTR = OFF_ROPE + 8192;
constexpr size_t OFF_GB = OFF_CTR + 256;
constexpr size_t OFF_XN = OFF_GB + (size_t)T_TOK * 32 * 4;
constexpr size_t OFF_MIX = OFF_XN + (size_t)T_TOK * 1024 * 2;
constexpr size_t OFF_HID = OFF_MIX + (size_t)T_TOK * 1024 * 2;
constexpr size_t OFF_ZA = OFF_HID + (size_t)T_TOK * DFF * 2;
constexpr size_t OFF_Q = OFF_ZA + (size_t)T_TOK * 2048 * 2;
constexpr size_t OFF_KP = OFF_Q + (size_t)T_TOK * 512 * 2;
constexpr size_t OFF_KS = OFF_KP + (size_t)T_P * 512 * 2;
constexpr size_t OFF_VTP = OFF_KS + (size_t)4 * 1280 * 512 * 2;
constexpr size_t OFF_VTS = OFF_VTP + (size_t)T_P * 512 * 2;
constexpr size_t OFF_BAR = OFF_VTS + (size_t)4 * 1280 * 512 * 2;
constexpr size_t WS_END = OFF_BAR + 16384;

constexpr size_t OUT_Y = 0;
constexpr size_t OUT_K = 12582912;
constexpr size_t OUT_V = 16777216;
constexpr size_t OUT_S = 20971520;

struct P {
  const float *x_prompt, *x_sample, *cache_k, *cache_v, *state, *c, *c_ctx, *w_ada, *b_ada,
      *norm_ffn1, *w_ffn1_in, *w_ffn1_out, *norm_mix, *w_in, *conv_w, *a_log, *dt_bias, *delta_norm,
      *lq1, *lk1, *lq2, *lk2, *diff_norm, *w_out, *norm_ffn2, *w_ffn2_in, *w_ffn2_out, *norm_final;
  float* out;
  char* ws;
  int plo, phi;
};

DI u16 f2bf(float x) { return __builtin_bit_cast(u16, (__bf16)x); }
DI float bf2f(u16 b) { return __uint_as_float(((unsigned)b) << 16); }
DI unsigned pack2(float a, float b) { return (unsigned)f2bf(a) | ((unsigned)f2bf(b) << 16); }
#define DPPF(v, ctrl, rmask) __int_as_float(__builtin_amdgcn_update_dpp(0, __float_as_int(v), ctrl, rmask, 0xf, false))
DI float wave_sum(float v) {
  v += DPPF(v, 0xB1, 0xf); v += DPPF(v, 0x4E, 0xf); v += DPPF(v, 0x141, 0xf); v += DPPF(v, 0x140, 0xf);
  v += DPPF(v, 0x142, 0xa); v += DPPF(v, 0x143, 0xc);
  return __int_as_float(__builtin_amdgcn_readlane(__float_as_int(v), 63));
}
DI float quad_bcast(float v, int k) {
  switch (k & 3) {
    case 0: return DPPF(v, 0x00, 0xf);
    case 1: return DPPF(v, 0x55, 0xf);
    case 2: return DPPF(v, 0xAA, 0xf);
    default: return DPPF(v, 0xFF, 0xf);
  }
}
DI float oct_sum(float v) {
  v += DPPF(v, 0xB1, 0xf); v += DPPF(v, 0x4E, 0xf); v += DPPF(v, 0x141, 0xf);
  return v;
}
typedef const P __attribute__((address_space(4)))* CP;
typedef const unsigned long long __attribute__((address_space(4)))* CU64;
DI int ltid(int wv) { unsigned m = ~0u; asm volatile("" : "+s"(m)); int t = wv * 64 + (int)__builtin_amdgcn_mbcnt_hi(m, __builtin_amdgcn_mbcnt_lo(m, 0u)); asm volatile("" : "+v"(t)); return t; }
DI P ldp(CP pp) {
  asm volatile("" : "+s"(pp));
  P p; CU64 s = (CU64)pp; unsigned long long* d = (unsigned long long*)&p;
#pragma unroll
  for (int i = 0; i < 31; ++i) d[i] = s[i];
  return p;
}

#define XB_TMO      128
#define XB_XCNT(j)  (256  + 64 * (j))
#define XB_XSUB(j)  (1280 + 64 * (j))
#define XB_XGEN(j)  (2304 + 64 * (j))
#define XB_TOP      3328
#define XB_TOPGEN   3392
#define XCD_BAR_WORDS 3456
#define XB_SPIN_CAP (1u << 20)
DI unsigned xb_ld(unsigned* p) { return __hip_atomic_load(p, __ATOMIC_RELAXED, __HIP_MEMORY_SCOPE_AGENT); }
DI unsigned xb_add(unsigned* p, unsigned v) { return __hip_atomic_fetch_add(p, v, __ATOMIC_RELAXED, __HIP_MEMORY_SCOPE_AGENT); }
DI unsigned xb_xcc_id() { return (unsigned)__builtin_amdgcn_s_getreg((3 << 11) | 20) & 0xFu; }
#define XB_SPIN(cond, bar) do { unsigned _sp = 0; while (cond) { __builtin_amdgcn_s_sleep(1); \
    if ((++_sp & 255u) == 0u) { if (xb_ld(&(bar)[XB_TMO])) break; if (_sp > XB_SPIN_CAP) { atomicAdd(&(bar)[XB_TMO], 1u); break; } } } } while (0)
DI void xcd_barrier_complete(unsigned* bar, unsigned x, unsigned& nloc, unsigned& nx) {
  const unsigned G = gridDim.x;
  unsigned sum, cnt, mine, sp = 0u;
  for (;;) {
    sum = 0u; cnt = 0u; mine = 0u;
#pragma unroll
    for (unsigned j = 0; j < 16; ++j) { const unsigned c = xb_ld(&bar[XB_XCNT(j)]); sum += c; cnt += (c > 0u) ? 1u : 0u; mine = (j == x) ? c : mine; }
    if (sum == G) break;
    __builtin_amdgcn_s_sleep(1);
    if ((++sp & 255u) == 0u) { if (xb_ld(&bar[XB_TMO])) break; if (sp > XB_SPIN_CAP) { atomicAdd(&bar[XB_TMO], 1u); break; } }
  }
  nloc = mine > 0u ? mine : 1u; nx = cnt > 0u ? cnt : 1u;
}
DI void gbar_post(CP pp, int wv) {
  volatile unsigned* st = (volatile unsigned*)(dsm + LDS_BYTES - 32);
  if (ltid(wv) == 0) {
    unsigned* bar = (unsigned*)(pp->ws + OFF_BAR);
    st[0] = 0u; st[1] = 0u;
    (void)xb_add(&bar[XB_XCNT(xb_xcc_id())], 1u);
  }
  __syncthreads();
}
DI void gbar(CP pp, int wv) {
  asm volatile("s_waitcnt vmcnt(0)" ::: "memory");
  __syncthreads();
  if (ltid(wv) == 0) {
    unsigned* bar = (unsigned*)(pp->ws + OFF_BAR);
    volatile unsigned* st = (volatile unsigned*)(dsm + LDS_BYTES - 32);
    const unsigned x = xb_xcc_id();
    __builtin_amdgcn_s_waitcnt(0);
    unsigned nloc = st[0], nx = st[1];
    if (nloc == 0u) { xcd_barrier_complete(bar, x, nloc, nx); st[0] = nloc; st[1] = nx; }
    const unsigned old = xb_add(&bar[XB_XSUB(x)], 1u);
    const unsigned gen = old / nloc;
    if (old + 1u == (gen + 1u) * nloc) {
      __builtin_amdgcn_fence(__ATOMIC_RELEASE, "agent");
      asm volatile("s_waitcnt vmcnt(0)" ::: "memory");
      const unsigned og = xb_add(&bar[XB_TOP], 1u);
      const unsigned tg = og / nx;
      if (og + 1u == (tg + 1u) * nx) xb_add(&bar[XB_TOPGEN], 1u);
      else XB_SPIN(xb_ld(&bar[XB_TOPGEN]) == tg, bar);
      __builtin_amdgcn_fence(__ATOMIC_ACQUIRE, "agent");
      xb_add(&bar[XB_XGEN(x)], 1u);
      asm volatile("s_waitcnt vmcnt(0)" ::: "memory");
    } else {
      XB_SPIN(xb_ld(&bar[XB_XGEN(x)]) == gen, bar);
      __builtin_amdgcn_fence(__ATOMIC_ACQUIRE, "agent");
      asm volatile("s_waitcnt vmcnt(0)" ::: "memory");
    }
  }
  __syncthreads();
}
DI float4 nt_load4(const float* p) { f32x4 v = __builtin_nontemporal_load((const f32x4*)p); return make_float4(v[0], v[1], v[2], v[3]); }
DI void nt_store4(float4 v, float* p) { f32x4 t = {v.x, v.y, v.z, v.w}; __builtin_nontemporal_store(t, (f32x4*)p); }
DI float siluf(float x) { return x * __builtin_amdgcn_rcpf(1.f + __builtin_amdgcn_exp2f(-1.4426950408889634f * x)); }
DI int tok_group(int t) { return t < T_P ? 0 : 1 + ((t - T_P) >> 10); }

DI void transpose_tile(const float* __restrict__ src, int nsrc, u16* __restrict__ dst, int K, int n0, int k0, int mode, int wv) {
  float* tl = (float*)dsm;
  const int tid = ltid(wv);
  float4 v[8];
#pragma unroll
  for (int i = 0; i < 8; ++i) {
    int e = tid + 512 * i;
    int k = e >> 6, n = n0 + (e & 63) * 4, sc;
    if (mode == 1 || (mode == 2 && (n < 2048 || (n >= 3072 && n < 3584)))) { const int rho = n & 31, nf = rho >> 4, i = rho & 15; n = (n & ~31) + 8 * (i >> 2) + 4 * nf + (i & 3); }
    if (mode == 1) { int pp = n >> 8, w = n & 255; sc = (w >> 7) * DFF + pp * 128 + (w & 127); }
    else if (mode == 2) { sc = n < 2048 ? n : (n < 3584 ? n + 32 : (n < 3616 ? n - 3584 + 2048 : -1)); }
    else sc = n;
    v[i] = sc >= 0 ? nt_load4(src + (size_t)(k0 + k) * nsrc + sc) : make_float4(0.f, 0.f, 0.f, 0.f);
  }
#pragma unroll
  for (int i = 0; i < 8; ++i) {
    int e = tid + 512 * i;
    int k = e >> 6, j = (e & 63) * 4;
    tl[k * 257 + j] = v[i].x; tl[k * 257 + j + 1] = v[i].y; tl[k * 257 + j + 2] = v[i].z; tl[k * 257 + j + 3] = v[i].w;
  }
  __syncthreads();
#pragma unroll
  for (int i = 0; i < 8; ++i) {
    int e = tid + 512 * i;
    int n = e >> 4, kq = (e & 15) * 4;
    u32x2 o;
    o.x = pack2(tl[kq * 257 + n], tl[(kq + 1) * 257 + n]);
    o.y = pack2(tl[(kq + 2) * 257 + n], tl[(kq + 3) * 257 + n]);
    *(u32x2*)(dst + (size_t)(n0 + n) * K + k0 + kq) = o;
  }
  __syncthreads();
}

DI void phase0(CP pp, int wv, int misc_first = -1, int misc_stride = 1) {
  const P p = ldp(pp);
  const bool misc = misc_first >= 0;
  const int tid = ltid(wv);
  u16* WB1 = (u16*)(p.ws + OFF_WB1); u16* WB2 = (u16*)(p.ws + OFF_WB2); u16* WB3 = (u16*)(p.ws + OFF_WB3);
  u16* WB4 = (u16*)(p.ws + OFF_WB4); u16* WB5 = (u16*)(p.ws + OFF_WB5); u16* WB6 = (u16*)(p.ws + OFF_WB6);
  float* MODP = (float*)(p.ws + OFF_MODP);
  constexpr int NA = 256;
  constexpr int S1 = NA, S2 = S1 + 352, S3 = S2 + 176, S4 = S3 + 240, S5 = S4 + 64, S6 = S5 + 352, S7 = S6 + 176;
  constexpr int S8 = S7 + 1, S9 = S8 + 16, S10 = S9 + 16;
  for (int it = misc ? S7 + misc_first : (int)blockIdx.x; it < (misc ? S10 : S2); it += misc ? misc_stride : (int)gridDim.x) {
    if (it >= S2 && it < S7) continue;
    if (it < NA) {
      float* sl = (float*)dsm;
      float* red = sl + 5120;
      __syncthreads();
      for (int e = tid; e < 5120; e += 512) {
        int g = e >> 10, k = e & 1023;
        float v = g == 0 ? p.c_ctx[k] : p.c[(g - 1) * 1024 + k];
        sl[e] = v / (1.f + expf(-v));
      }
      __syncthreads();
      const int c0 = it * 36;
      if (tid < 504) {
        const int kg = tid / 36, col = tid - kg * 36;
        float a0 = 0, a1 = 0, a2 = 0, a3 = 0, a4 = 0;
        const float* wp = p.w_ada + c0 + col;
#pragma unroll 1
        for (int i0 = 0; i0 < 74; i0 += 19) {
          float wv_[19];
#pragma unroll
          for (int j = 0; j < 19; ++j) { const int k = kg + 14 * (i0 + j); wv_[j] = (i0 + j < 74 && k < 1024) ? __builtin_nontemporal_load(wp + (size_t)k * 9216) : 0.f; }
#pragma unroll
          for (int j = 0; j < 19; ++j) {
            const int k = min(kg + 14 * (i0 + j), 1023); const float w = wv_[j];
            a0 += sl[k] * w; a1 += sl[1024 + k] * w; a2 += sl[2048 + k] * w; a3 += sl[3072 + k] * w; a4 += sl[4096 + k] * w;
          }
        }
        float* r = red + (kg * 36 + col) * 5;
        r[0] = a0; r[1] = a1; r[2] = a2; r[3] = a3; r[4] = a4;
      }
      __syncthreads();
      if (tid < 180) {
        const int col = tid / 5, g = tid - col * 5;
        float a = p.b_ada[c0 + col];
#pragma unroll
        for (int kg = 0; kg < 14; ++kg) a += red[(kg * 36 + col) * 5 + g];
        ((float*)(p.ws + OFF_MOD))[g * 9216 + c0 + col] = a;
      }
      __syncthreads();
    } else if (it < S2) { int id = it - S1; transpose_tile(p.w_ffn1_in, 5632, WB1, 1024, (id % 22) * 256, (id / 22) * 64, 1, wv); }
    else if (it < S3) { int id = it - S2; transpose_tile(p.w_ffn1_out, 1024, WB2, DFF, (id % 4) * 256, (id / 4) * 64, 0, wv); }
    else if (it < S4) { int id = it - S3; transpose_tile(p.w_in, 3616, WB3, 1024, (id % 15) * 256, (id / 15) * 64, 2, wv); }
    else if (it < S5) { int id = it - S4; transpose_tile(p.w_out, 1024, WB4, 1024, (id % 4) * 256, (id / 4) * 64, 0, wv); }
    else if (it < S6) { int id = it - S5; transpose_tile(p.w_ffn2_in, 5632, WB5, 1024, (id % 22) * 256, (id / 22) * 64, 1, wv); }
    else if (it < S7) { int id = it - S6; transpose_tile(p.w_ffn2_out, 1024, WB6, DFF, (id % 4) * 256, (id / 4) * 64, 0, wv); }
    else if (it < S8) {
      float* rope = (float*)(p.ws + OFF_ROPE);
      for (int e = tid; e < 1024; e += 512) {
        int pos = e >> 4, i = e & 15;
        float inv = powf(10000.f, -(float)i / 16.f);
        float ang = (float)pos * inv;
        rope[e] = cosf(ang); rope[1024 + e] = sinf(ang);
      }
      if (tid < 4) ((int*)(p.ws + OFF_CTR))[tid] = 0;
    } else if (it < S9) {
      int id = it - S8;
      u16* KS = (u16*)(p.ws + OFF_KS);
      for (int e = tid; e < 64 * 256; e += 512) {
        int rr = id * 64 + (e >> 8), c2 = (e & 255) * 2;
        int b = rr >> 8, j = rr & 255;
        const float* s = p.cache_k + (size_t)rr * 512 + c2;
        const int rho = c2 & 31, cp2 = (c2 & ~31) + 8 * ((rho & 15) >> 2) + 4 * (rho >> 4) + (rho & 3);
        *(unsigned*)(KS + ((size_t)b * 1280 + j) * 512 + cp2) = pack2(s[0], s[1]);
      }
    } else {
      int id = it - S9;
      u16* VS = (u16*)(p.ws + OFF_VTS);
      for (int e = tid; e < 64 * 256; e += 512) {
        int rr = id * 64 + (e >> 8), c2 = (e & 255) * 2;
        int b = rr >> 8, j = rr & 255;
        const float* s = p.cache_v + (size_t)rr * 512 + c2;
        *(unsigned*)(VS + ((size_t)b * 1280 + j) * 512 + c2) = pack2(s[0], s[1]);
      }
    }
  }
}

template <int which>
DI void norm_phase(CP pp, int wv) {
  const P p = ldp(pp);
  const int tid = ltid(wv), lane = tid & 63, wid = tid >> 6;
  const float* MODP = (const float*)(p.ws + OFF_MODP);
  float* MOD = (float*)(p.ws + OFF_MOD);
  u16* XN = (u16*)(p.ws + OFF_XN);
  const float* gain = which == 0 ? p.norm_ffn1 : which == 1 ? p.norm_mix : which == 2 ? p.norm_ffn2 : p.norm_final;
  constexpr int s_shift = which == 0 ? 0 : which == 1 ? 3 : 6;
  float4 gn[4], sh[4], sc[4];
#pragma unroll
  for (int i = 0; i < 4; ++i) gn[i] = *(const float4*)(gain + i * 256 + lane * 4);
  int gcur = -1;
  for (int w = blockIdx.x * 8 + wid; w < 2048; w += gridDim.x * 8)
  for (int half = 0; half < 1; ++half) {
    const int t0 = w * 6;
    if (which != 3) {
      const int g0 = tok_group(t0);
      if (g0 != gcur) {
        gcur = g0;
#pragma unroll
        for (int i = 0; i < 4; ++i) {
          sh[i] = *(const float4*)(MOD + (g0 * 9 + s_shift) * 1024 + i * 256 + lane * 4);
          sc[i] = *(const float4*)(MOD + (g0 * 9 + s_shift + 1) * 1024 + i * 256 + lane * 4);
        }
      }
    }
    float4 xv[6][4];
#pragma unroll
    for (int rr = 0; rr < 6; ++rr) {
      const int t = t0 + rr;
      const float* xr = which == 0 ? (t < T_P ? p.x_prompt + (size_t)t * 1024 : p.x_sample + (size_t)(t - T_P) * 1024)
                                   : p.out + OUT_Y + (size_t)t * 1024;
#pragma unroll
      for (int i = 0; i < 4; ++i) xv[rr][i] = *(const float4*)(xr + i * 256 + lane * 4);
    }
#pragma unroll
    for (int rr = 0; rr < 6; ++rr) {
      const int t = t0 + rr;
      float ss = 0.f;
#pragma unroll
      for (int i = 0; i < 4; ++i) ss += xv[rr][i].x * xv[rr][i].x + xv[rr][i].y * xv[rr][i].y + xv[rr][i].z * xv[rr][i].z + xv[rr][i].w * xv[rr][i].w;
      ss = wave_sum(ss);
      const float rstd = rsqrtf(ss * (1.f / 1024.f) + 1e-6f);
      if (which == 3) {
        float* orow = p.out + OUT_Y + (size_t)t * 1024;
#pragma unroll
        for (int i = 0; i < 4; ++i) {
          float4 o;
          o.x = xv[rr][i].x * rstd * gn[i].x; o.y = xv[rr][i].y * rstd * gn[i].y;
          o.z = xv[rr][i].z * rstd * gn[i].z; o.w = xv[rr][i].w * rstd * gn[i].w;
          nt_store4(o, orow + i * 256 + lane * 4);
        }
      } else {
        const int g = tok_group(t);
        if (g != gcur) {
          gcur = g;
#pragma unroll
          for (int i = 0; i < 4; ++i) {
            const int col = i * 256 + lane * 4;
            {
              sh[i] = *(const float4*)(MOD + (g * 9 + s_shift) * 1024 + col);
              sc[i] = *(const float4*)(MOD + (g * 9 + s_shift + 1) * 1024 + col);
            }
          }
        }
#pragma unroll
        for (int i = 0; i < 4; ++i) {
          float y0 = xv[rr][i].x * rstd * gn[i].x * (1.f + sc[i].x) + sh[i].x;
          float y1 = xv[rr][i].y * rstd * gn[i].y * (1.f + sc[i].y) + sh[i].y;
          float y2 = xv[rr][i].z * rstd * gn[i].z * (1.f + sc[i].z) + sh[i].z;
          float y3 = xv[rr][i].w * rstd * gn[i].w * (1.f + sc[i].w) + sh[i].w;
          u32x2 o; o.x = pack2(y0, y1); o.y = pack2(y2, y3);
          *(u32x2*)(XN + (size_t)t * 1024 + i * 256 + lane * 4) = o;
        }
      }
    }
  }
}

constexpr int BM = 256, BK = 64, HALF = 128, HT = HALF * BK;

DI int lds_byte(int r, int c) {
  int st = (r >> 4) * 2 + (c >> 5), rr = r & 15, cc = c & 31, ob = rr * 64 + cc * 2;
  return st * 1024 + (ob ^ (((ob >> 9) & 1) << 5));
}
DI void stage_rc(int b, int& R, int& C) {
  int st = b / 1024, sb = b % 1024, swz = sb ^ (((sb >> 9) & 1) << 5);
  R = (st >> 1) * 16 + swz / 64; C = (st & 1) * 32 + (swz % 64) / 2;
}

template <int MT, class Epi>
DI void gemm_phase(const u16* __restrict__ A, const u16* __restrict__ Bt, const int K, const int nM, const int nN, Epi epi, int wv) {
  u16* shm = (u16*)dsm;
#define SA(b, h) (shm + ((b) * 2 + (h)) * HT)
#define SB(b, h) (shm + (4 + (b) * 2 + (h)) * HT)
#define STAGE(Pp, BASE, br, kt) do { const char* _gb = (const char*)(BASE) + ((size_t)(br) * K + (size_t)(kt) * BK) * 2; \
    __builtin_amdgcn_global_load_lds((const unsigned*)(_gb + voff0), (unsigned*)((char*)(Pp) + tidl * 16), 16, 0, 0); \
    __builtin_amdgcn_global_load_lds((const unsigned*)(_gb + voff1), (unsigned*)((char*)(Pp) + tidl * 16 + 8192), 16, 0, 0); } while (0)
#define LDA(dst, b, h) for (int m = 0; m < MT; ++m) for (int k = 0; k < 2; ++k) \
    dst[m][k] = *reinterpret_cast<const bf16x8*>((char*)SA(b, h) + lds_byte(wr * (MT * 16) + m * 16 + fr, k * 32 + fq * 8))
#define LDB(dst, b, h) for (int n = 0; n < 2; ++n) for (int k = 0; k < 2; ++k) \
    dst[n][k] = *reinterpret_cast<const bf16x8*>((char*)SB(b, h) + lds_byte(wc * 32 + n * 16 + fr, k * 32 + fq * 8))
#define MMA(ai, bj, At_, Bt_) do { __builtin_amdgcn_s_setprio(1); \
    for (int m = 0; m < MT; ++m) for (int n = 0; n < 2; ++n) for (int k = 0; k < 2; ++k) \
      acc[ai][bj][m][n] = __builtin_amdgcn_mfma_f32_16x16x32_bf16(Bt_[n][k], At_[m][k], acc[ai][bj][m][n], 0, 0, 0); \
    __builtin_amdgcn_s_setprio(0); } while (0)
#define WAIT_V(n) asm volatile("s_waitcnt vmcnt(" #n ")" ::: "memory")
#define WAIT_L(n) asm volatile("s_waitcnt lgkmcnt(" #n ")" ::: "memory")
#define WAIT_LA do { if (MT == 4) asm volatile("s_waitcnt lgkmcnt(8)" ::: "memory"); else asm volatile("s_waitcnt lgkmcnt(6)" ::: "memory"); } while (0)
#define BAR __builtin_amdgcn_s_barrier()
#define SCHED __builtin_amdgcn_sched_barrier(0)

  const int ntiles = nM * nN, per = ntiles / 8;
  const int nt = K / BK;
  int tix = blockIdx.x;
  if (tix < ntiles) {
    const int tidl = ltid(wv);
    const int wid = tidl >> 6, lane = tidl & 63, wr = wid >> 2, wc = wid & 3, fr = lane & 15, fq = lane >> 4;
    unsigned voff0, voff1;
    { int _r, _c; stage_rc(tidl * 16, _r, _c); voff0 = (unsigned)(_r * K + _c) * 2u;
      stage_rc(tidl * 16 + 8192, _r, _c); voff1 = (unsigned)(_r * K + _c) * 2u; }
    const int wgm = nM >> 3, nig = wgm * nN;
    int pm, pn;
    { int lid = (tix & 7) * per + (tix >> 3); int grp = lid / nig, within = lid - grp * nig; pm = grp * wgm + within % wgm; pn = within / wgm; }
    int brow = pm * (MT * 64), bcol = pn * BM;
    bf16x8 At[MT][2], B0[2][2], B1[2][2];
    STAGE(SB(0, 0), Bt, bcol, 0); STAGE(SA(0, 0), A, brow, 0);
    STAGE(SB(0, 1), Bt, bcol + HALF, 0); STAGE(SA(0, 1), A, brow + MT * 32, 0);
    if (wr == 1) BAR;
    WAIT_V(4); BAR;
    STAGE(SB(1, 0), Bt, bcol, 1); STAGE(SA(1, 0), A, brow, 1); STAGE(SB(1, 1), Bt, bcol + HALF, 1);
    WAIT_V(6); BAR;
    while (true) {
      const int ntix = tix + gridDim.x;
      const bool has_next = ntix < ntiles;
      int npm, npn;
      { int lid = ((has_next ? ntix : tix) & 7) * per + ((has_next ? ntix : tix) >> 3); int grp = lid / nig, within = lid - grp * nig; npm = grp * wgm + within % wgm; npn = within / wgm; }
      const int nbrow = npm * (MT * 64), nbcol = npn * BM;
      f32x4 acc[2][2][MT][2] = {};
      for (int t = 0; t < nt; t += 2) {
        const bool last = t + 2 >= nt;
        const int rA = last ? nbrow : brow, rB = last ? nbcol : bcol, k2 = last ? 0 : t + 2, k3 = last ? 1 : t + 3;
        LDB(B0, 0, 0); SCHED; LDA(At, 0, 0); STAGE(SA(1, 1), A, brow + MT * 32, t + 1);
        WAIT_LA; BAR; WAIT_L(0); MMA(0, 0, At, B0); BAR; SCHED;
        LDB(B1, 0, 1); STAGE(SB(0, 0), Bt, rB, k2);
        BAR; WAIT_L(0); MMA(0, 1, At, B1); BAR;
        LDA(At, 0, 1); STAGE(SA(0, 0), A, rA, k2);
        BAR; WAIT_L(0); MMA(1, 0, At, B0); BAR; SCHED;
        STAGE(SB(0, 1), Bt, rB + HALF, k2);
        WAIT_V(6); BAR; MMA(1, 1, At, B1); BAR;
        LDB(B0, 1, 0); SCHED; LDA(At, 1, 0); STAGE(SA(0, 1), A, rA + MT * 32, k2);
        WAIT_LA; BAR; WAIT_L(0); MMA(0, 0, At, B0); BAR; SCHED;
        LDB(B1, 1, 1); STAGE(SB(1, 0), Bt, rB, k3);
        BAR; WAIT_L(0); MMA(0, 1, At, B1); BAR;
        LDA(At, 1, 1); STAGE(SA(1, 0), A, rA, k3);
        BAR; WAIT_L(0); MMA(1, 0, At, B0); BAR; SCHED;
        STAGE(SB(1, 1), Bt, rB + HALF, k3);
        WAIT_V(6); BAR; MMA(1, 1, At, B1); BAR;
      }
      {
        int t2 = ltid(wv);
        const int wid2 = t2 >> 6, lane2 = t2 & 63;
        epi(pm, pn, acc, wid2 >> 2, wid2 & 3, lane2 & 15, lane2 >> 4);
      }
      WAIT_V(0);
      if (!has_next) break;
      tix = ntix; pm = npm; pn = npn; brow = nbrow; bcol = nbcol;
    }
    if (wr == 0) BAR;
    __syncthreads();
  }
#undef WAIT_LA
#undef SA
#undef SB
#undef STAGE
#undef LDA
#undef LDB
#undef MMA
}

struct EpiSwiGLU {
  u16* HID;
  DI void operator()(int pm, int pn, f32x4 (&acc)[2][2][4][2], int wr, int wc, int fr, int fq) const {
#pragma unroll
    for (int ai = 0; ai < 2; ++ai)
#pragma unroll
      for (int m = 0; m < 4; ++m) {
        int t = pm * 256 + ai * 128 + wr * 64 + m * 16 + fr;
        {
          const int hc = pn * 128 + wc * 32 + fq * 8;
          f32x4 g0 = acc[ai][0][m][0], u0 = acc[ai][1][m][0], g1 = acc[ai][0][m][1], u1 = acc[ai][1][m][1];
          u32x4 o;
          o.x = pack2(siluf(g0[0]) * u0[0], siluf(g0[1]) * u0[1]);
          o.y = pack2(siluf(g0[2]) * u0[2], siluf(g0[3]) * u0[3]);
          o.z = pack2(siluf(g1[0]) * u1[0], siluf(g1[1]) * u1[1]);
          o.w = pack2(siluf(g1[2]) * u1[2], siluf(g1[3]) * u1[3]);
          *(u32x4*)(HID + (size_t)t * DFF + hc) = o;
        }
      }
  }
};

struct EpiResid {
  const float* xp; const float* xs;
  float* out; const float* MOD; int slot; float coef;
  DI void operator()(int pm, int pn, f32x4 (&acc)[2][2][4][2], int wr, int wc, int fr, int fq) const {
    const int g = pm < 32 ? 0 : 1 + ((pm - 32) >> 2);
    const float* gate = MOD + (g * 9 + slot) * 1024 + pn * 256;
    const float* xin = pm < 32 ? xp + (size_t)pm * 262144 + pn * 256 : xs + (size_t)(pm - 32) * 262144 + pn * 256;
    float* o = out + (size_t)pm * 262144 + pn * 256;
    const unsigned cbase = wc * 32 + fq * 4, rbase = wr * 64 + fr;
#pragma unroll
    for (int bj = 0; bj < 2; ++bj)
#pragma unroll
      for (int n = 0; n < 2; ++n) {
        const unsigned col = cbase + bj * 128 + n * 16;
        const float4 gt = *(const float4*)(gate + col);
#pragma unroll
        for (int aim = 0; aim < 4; ++aim) {
          const int ai = aim >> 1;
          asm volatile("" ::: "memory");
          float4 xi[2][4];
#pragma unroll
          for (int m = (aim & 1) * 2; m < (aim & 1) * 2 + 2; ++m) xi[ai][m] = *(const float4*)(xin + (rbase + ai * 128 + m * 16) * 1024u + col);
#pragma unroll
          for (int m = (aim & 1) * 2; m < (aim & 1) * 2 + 2; ++m) {
            const unsigned off = (rbase + ai * 128 + m * 16) * 1024u + col;
            f32x4 a = acc[ai][bj][m][n];
            float4 r;
            r.x = xi[ai][m].x + coef * gt.x * a[0]; r.y = xi[ai][m].y + coef * gt.y * a[1];
            r.z = xi[ai][m].z + coef * gt.z * a[2]; r.w = xi[ai][m].w + coef * gt.w * a[3];
            *(float4*)(o + off) = r;
          }
        }
      }
  }
};

struct EpiResid192 {
  const float* xp; const float* xs; float* out; const float* MOD; int slot; float coef;
  DI void operator()(int pm, int pn, f32x4 (&acc)[2][2][3][2], int wr, int wc, int fr, int fq) const {
    const unsigned cbase = pn * 256 + wc * 32 + fq * 4;
#pragma unroll
    for (int bj = 0; bj < 2; ++bj) {
      asm volatile("" ::: "memory");
      float4 xi[2][3][2];
#pragma unroll
      for (int ai = 0; ai < 2; ++ai)
#pragma unroll
        for (int m = 0; m < 3; ++m) {
          const int t = pm * 192 + ai * 96 + wr * 48 + m * 16 + fr;
          const float* xin = t < T_P ? xp + (size_t)t * 1024 : xs + (size_t)(t - T_P) * 1024;
#pragma unroll
          for (int n = 0; n < 2; ++n) xi[ai][m][n] = *(const float4*)(xin + cbase + bj * 128 + n * 16);
        }
#pragma unroll
      for (int ai = 0; ai < 2; ++ai)
#pragma unroll
        for (int m = 0; m < 3; ++m) {
          const int t = pm * 192 + ai * 96 + wr * 48 + m * 16 + fr;
          const float* gate = MOD + (tok_group(t) * 9 + slot) * 1024;
          float* o = out + (size_t)t * 1024;
#pragma unroll
          for (int n = 0; n < 2; ++n) {
            const float4 gt = *(const float4*)(gate + cbase + bj * 128 + n * 16);
            f32x4 a = acc[ai][bj][m][n];
            float4 r;
            r.x = xi[ai][m][n].x + coef * gt.x * a[0]; r.y = xi[ai][m][n].y + coef * gt.y * a[1];
            r.z = xi[ai][m][n].z + coef * gt.z * a[2]; r.w = xi[ai][m][n].w + coef * gt.w * a[3];
            *(float4*)(o + cbase + bj * 128 + n * 16) = r;
          }
        }
    }
  }
};

struct EpiInProj {
  char* ws; float* out;
  DI void operator()(int pm, int pn, f32x4 (&acc)[2][2][4][2], int wr, int wc, int fr, int fq) const {
    const bool sample = pm >= 32;
    const unsigned rbase = wr * 64 + fr;
    const unsigned cb0 = wc * 32 + fq * 4;
    if (pn < 8) {
      u16* ZA = (u16*)(ws + OFF_ZA) + (size_t)pm * 256 * 2048 + pn * 256;
#pragma unroll
      for (int ai = 0; ai < 2; ++ai)
#pragma unroll
        for (int m = 0; m < 4; ++m)
#pragma unroll
          for (int bj = 0; bj < 2; ++bj) {
            f32x4 a = acc[ai][bj][m][0], b = acc[ai][bj][m][1];
            u32x4 o; o.x = pack2(a[0], a[1]); o.y = pack2(a[2], a[3]); o.z = pack2(b[0], b[1]); o.w = pack2(b[2], b[3]);
            *(u32x4*)(ZA + (rbase + ai * 128 + m * 16) * 2048u + wc * 32 + fq * 8 + bj * 128) = o;
          }
    } else if (pn < 12) {
      const bool isq = pn < 10;
      const float* rope = (const float*)(ws + OFF_ROPE);
      const unsigned cq = (pn & 1) * 256 + cb0;
      u16* dstb;
      unsigned rstride = 512;
      if (isq) dstb = (u16*)(ws + OFF_Q) + (size_t)pm * 256 * 512;
      else if (!sample) dstb = (u16*)(ws + OFF_KP) + (size_t)pm * 256 * 512;
      else dstb = (u16*)(ws + OFF_KS) + ((size_t)((pm - 32) >> 2) * 1280 + 256 + ((pm - 32) & 3) * 256) * 512;
      float* ko = out + OUT_K + (size_t)pm * 256 * 512;
      const int slb = ((pm - 32) & 3) * 256;
#pragma unroll
      for (int ai = 0; ai < 2; ++ai) {
        asm volatile("" ::: "memory");
        float4 csv[4], snv[4];
#pragma unroll
        for (int m = 0; m < 4; ++m) {
          csv[m] = make_float4(1.f, 1.f, 1.f, 1.f); snv[m] = make_float4(0.f, 0.f, 0.f, 0.f);
          if (sample) {
            int sl = slb + rbase + ai * 128 + m * 16;
            int pos = (wc & 1) ? (sl & 63) : (sl >> 6);
            csv[m] = *(const float4*)(rope + pos * 16 + fq * 4);
            snv[m] = *(const float4*)(rope + 1024 + pos * 16 + fq * 4);
          }
        }
#pragma unroll
        for (int m = 0; m < 4; ++m) {
          const unsigned row = rbase + ai * 128 + m * 16;
          const float4 cs = csv[m], sn = snv[m];
#pragma unroll
          for (int bj = 0; bj < 2; ++bj) {
            f32x4 v1 = acc[ai][bj][m][0], v2 = acc[ai][bj][m][1];
            const unsigned off = row * rstride + cq + bj * 128;
            if (!sample && !isq) {
              nt_store4(make_float4(v1[0], v1[1], v1[2], v1[3]), ko + off);
              nt_store4(make_float4(v2[0], v2[1], v2[2], v2[3]), ko + off + 16);
            }
            f32x4 o1, o2;
            o1[0] = v1[0] * cs.x - v2[0] * sn.x; o2[0] = v2[0] * cs.x + v1[0] * sn.x;
            o1[1] = v1[1] * cs.y - v2[1] * sn.y; o2[1] = v2[1] * cs.y + v1[1] * sn.y;
            o1[2] = v1[2] * cs.z - v2[2] * sn.z; o2[2] = v2[2] * cs.z + v1[2] * sn.z;
            o1[3] = v1[3] * cs.w - v2[3] * sn.w; o2[3] = v2[3] * cs.w + v1[3] * sn.w;
            if (isq) { o1 *= 0.18033688011112042f; o2 *= 0.18033688011112042f; }
            u32x2 o1p, o2p;
            o1p.x = pack2(o1[0], o1[1]); o1p.y = pack2(o1[2], o1[3]);
            o2p.x = pack2(o2[0], o2[1]); o2p.y = pack2(o2[2], o2[3]);
            {
              u32x4 oq; oq.x = o1p.x; oq.y = o1p.y; oq.z = o2p.x; oq.w = o2p.y;
              *(u32x4*)(dstb + row * rstride + (pn & 1) * 256 + bj * 128 + wc * 32 + fq * 8) = oq;
            }
          }
        }
      }
    } else if (pn < 14) {
      const unsigned cv0 = (pn & 1) * 256 + wc * 32 + fq * 8;
      float* vo = out + OUT_V + (size_t)pm * 256 * 512;
      u16* vb = sample ? (u16*)(ws + OFF_VTS) + ((size_t)((pm - 32) >> 2) * 1280 + 256 + ((pm - 32) & 3) * 256) * 512
                       : (u16*)(ws + OFF_VTP) + (size_t)pm * 256 * 512;
#pragma unroll
      for (int ai = 0; ai < 2; ++ai)
#pragma unroll
        for (int m = 0; m < 4; ++m)
#pragma unroll
          for (int bj = 0; bj < 2; ++bj) {
            f32x4 a = acc[ai][bj][m][0], b = acc[ai][bj][m][1];
            const unsigned off = (rbase + ai * 128 + m * 16) * 512u + cv0 + bj * 128;
            if (!sample) {
              nt_store4(make_float4(a[0], a[1], a[2], a[3]), vo + off);
              nt_store4(make_float4(b[0], b[1], b[2], b[3]), vo + off + 4);
            }
            u32x4 o; o.x = pack2(a[0], a[1]); o.y = pack2(a[2], a[3]); o.z = pack2(b[0], b[1]); o.w = pack2(b[2], b[3]);
            *(u32x4*)(vb + off) = o;
          }
    } else {
      if (wc == 0) {
        float* GB = (float*)(ws + OFF_GB) + (size_t)pm * 256 * 32;
#pragma unroll
        for (int ai = 0; ai < 2; ++ai)
#pragma unroll
          for (int m = 0; m < 4; ++m)
#pragma unroll
            for (int n = 0; n < 2; ++n) {
              f32x4 a = acc[ai][0][m][n];
              *(float4*)(GB + (rbase + ai * 128 + m * 16) * 32u + n * 16 + fq * 4) = make_float4(a[0], a[1], a[2], a[3]);
            }
      }
    }
  }
};

constexpr int LQS = 0, LKB = 9216, LVB = 18432, LA = 27648, LQK = 44032, LKG = 53248, LST = 62464, LSM = 71680, HSZ = 73216, LW2 = 81920, LU2 = 91136;

DI f32x4 mma16(bf16x8 a, bf16x8 b, f32x4 c) { return __builtin_amdgcn_mfma_f32_16x16x32_bf16(a, b, c, 0, 0, 0); }
DI f32x4 mma_nt64(const char* Aop, const char* Bop, int i0, int j0, int fr, int fq, f32x4 acc) {
#pragma unroll
  for (int ks = 0; ks < 2; ++ks) {
    bf16x8 a = *(const bf16x8*)(Aop + (i0 + fr) * 144 + (ks * 32 + fq * 8) * 2);
    bf16x8 b = *(const bf16x8*)(Bop + (j0 + fr) * 144 + (ks * 32 + fq * 8) * 2);
    acc = mma16(a, b, acc);
  }
  return acc;
}

constexpr int LCW = HSZ;
DI void conv_decode(int item, int& m, int& h, int& L, int& base) {
  if (item < 1024) { const int seq = item >> 5; m = (item >> 3) & 3; h = item & 7; L = 256; base = seq * 256; }
  else { const int i2 = item - 1024; m = (i2 >> 3) & 15; h = i2 & 7; L = 1024; base = T_P + (i2 >> 7) * 1024; }
}
DI void conv_load(const P& p, const u16* ZA, int item, int tid, u32x4 (&zr)[4], float (&cwv)[2]) {
  int m, h, L, base; conv_decode(item, m, h, L, base);
#pragma unroll
  for (int i = 0; i < 4; ++i) {
    int id = tid + 512 * i;
    int row = id / 24, rem = id - row * 24;
    int s = m * 64 - 2 + row;
    u32x4 v = {0u, 0u, 0u, 0u};
    if (id < 1632 && s >= 0 && s < L) v = *(const u32x4*)(ZA + (size_t)(base + s) * 2048 + (rem >> 3) * 512 + h * 64 + (rem & 7) * 8);
    zr[i] = v;
  }
#pragma unroll
  for (int i = 0; i < 2; ++i) {
    int e = tid + 512 * i; cwv[i] = 0.f;
    if (e < 960) { int part = e / 320, r2 = e - part * 320, j = r2 >> 6, d = r2 & 63; cwv[i] = p.conv_w[j * 1536 + part * 512 + h * 64 + d]; }
  }
}
DI void conv_phase(CP pp, int wv) {
  const P p = ldp(pp);
  const u16* ZA = (const u16*)(p.ws + OFF_ZA);
  u16* QK = (u16*)(p.ws + OFF_XN);
  u16* VV = (u16*)(p.ws + OFF_WB1);
  u32x4 zr[4]; float cwv[2];
  if ((int)blockIdx.x < 1536) conv_load(p, ZA, blockIdx.x, ltid(wv), zr, cwv);
  for (int item = blockIdx.x; item < 1536; item += gridDim.x) {
    int m, h, L, base; conv_decode(item, m, h, L, base);
    const int tid = ltid(wv), lw = tid >> 6, lane = tid & 63;
    __syncthreads();
#pragma unroll
    for (int i = 0; i < 4; ++i) { int id = tid + 512 * i; if (id < 1632) *(u32x4*)(dsm + id * 16) = zr[i]; }
#pragma unroll
    for (int i = 0; i < 2; ++i) { int e = tid + 512 * i; if (e < 960) ((float*)(dsm + 26624))[e] = cwv[i]; }
    __syncthreads();
    if (item + (int)gridDim.x < 1536) conv_load(p, ZA, item + gridDim.x, tid, zr, cwv);
    {
      const int d = lane, so = lw * 8;
      const float* cwl = (const float*)(dsm + 26624);
#pragma unroll
      for (int part = 0; part < 3; ++part) {
        float cw[5];
#pragma unroll
        for (int j = 0; j < 5; ++j) cw[j] = cwl[part * 320 + j * 64 + d];
        float zv[12];
#pragma unroll
        for (int i = 0; i < 12; ++i) zv[i] = bf2f(*(const u16*)(dsm + (so + i) * 384 + part * 128 + d * 2));
#pragma unroll
        for (int i = 0; i < 8; ++i) {
          float v = cw[0] * zv[i] + cw[1] * zv[i + 1] + cw[2] * zv[i + 2] + cw[3] * zv[i + 3] + cw[4] * zv[i + 4];
          v = siluf(v);
          if (part < 2) {
            float ss = wave_sum(v * v);
            v *= rsqrtf(ss + 1e-6f);
            if (part == 0) v *= 0.125f;
          }
          const size_t t = (size_t)(base + m * 64 + so + i);
          if (part < 2) QK[((t * 8 + h) * 2 + part) * 64 + d] = f2bf(v);
          else VV[(t * 8 + h) * 64 + d] = f2bf(v);
        }
      }
    }
  }
  __syncthreads();
}
DI void dn_prefetch(const u16* QK, const u16* VV, const float* GB, int base, int mch, int hf, int h, int tid, u32x4 (&zr)[3], float& gad, float& gab) {
  const int r = (tid & 511) >> 3, cp = tid & 7;
  const size_t t = (size_t)(base + mch * 64 + r);
  zr[0] = *(const u32x4*)(QK + ((t * 8 + h) * 2 + 0) * 64 + cp * 8);
  zr[1] = *(const u32x4*)(QK + ((t * 8 + h) * 2 + 1) * 64 + cp * 8);
  zr[2] = *(const u32x4*)(VV + (t * 8 + h) * 64 + cp * 8);
  if (tid < 64) {
    int tk = base + mch * 64 + (hf ? 63 - tid : tid);
    gad = GB[(size_t)tk * 32 + hf * 8 + h];
    gab = GB[(size_t)tk * 32 + 16 + hf * 8 + h];
  }
}

DI void deltanet_item(const P& p, int item, int wv) {
  const int seq = item >> 4, h = (item >> 1) & 7, hf = item & 1;
  const bool sample = seq >= 32;
  const int L = sample ? 1024 : 256, N = L >> 6;
  const int base = sample ? T_P + (seq - 32) * 1024 : seq * 256;
  const u16* QK = (const u16*)(p.ws + OFF_XN);
  const u16* VV = (const u16*)(p.ws + OFF_WB1);
  const float* GB = (const float*)(p.ws + OFF_GB);
  char* hb = dsm;
  float* sm = (float*)(hb + LSM);
  u16* OB = (u16*)(p.ws + OFF_HID) + (size_t)hf * T_TOK * 512;
  const float alog = -expf(p.a_log[hf * 8 + h]);
  const float dtb = p.dt_bias[hf * 8 + h];

  f32x4 sacc[2];
  u32x4 zr[3]; float gad = 0.f, gab = 0.f;
  {
    const int tid = ltid(wv), lw = tid >> 6, lane = tid & 63, fr = lane & 15, fq = lane >> 4;
    dn_prefetch(QK, VV, GB, base, hf ? N - 1 : 0, hf, h, tid, zr, gad, gab);
#pragma unroll
    for (int k = 0; k < 2; ++k) {
      const int dt = 2 * (lw >> 2) + k, et = lw & 3;
      if (sample) {
        const float* s0 = p.state + (((size_t)(seq - 32) * 2 + hf) * 8 + h) * 4096;
#pragma unroll
        for (int r = 0; r < 4; ++r) sacc[k][r] = s0[(dt * 16 + fq * 4 + r) * 64 + et * 16 + fr];
      } else {
        sacc[k] = f32x4{0.f, 0.f, 0.f, 0.f};
      }
      u32x2 o; o.x = pack2(sacc[k][0], sacc[k][1]); o.y = pack2(sacc[k][2], sacc[k][3]);
      *(u32x2*)(hb + LST + (et * 16 + fr) * 144 + (dt * 16 + fq * 4) * 2) = o;
    }
  }

  for (int n = 0; n < N; ++n) {
    const int tid = ltid(wv);
    const int lw = tid >> 6, lane = tid & 63, fr = lane & 15, fq = lane >> 4;
    const int wq = lw & 3, wh = lw >> 2;
    const int mch = hf ? N - 1 - n : n;
    {
      const int r = tid >> 3, cp = tid & 7, c = hf ? 63 - r : r;
      *(u32x4*)(hb + LQS + c * 144 + cp * 16) = zr[0];
      *(u32x4*)(hb + LKB + c * 144 + cp * 16) = zr[1];
      *(u32x4*)(hb + LVB + c * 144 + cp * 16) = zr[2];
    }
    if (lw == 0) {
      const int c = lane;
      const float ad = gad + dtb;
      float sp = ad > 20.f ? ad : log1pf(expf(ad));
      float g = alog * sp;
      float bt = 1.f / (1.f + expf(-gab));
      float gc = g;
#pragma unroll
      for (int o = 1; o < 64; o <<= 1) { float v = __shfl_up(gc, o); if (lane >= o) gc += v; }
      float gl = __shfl(gc, 63);
      const float egc_ = expf(gc);
      sm[c] = gc; sm[64 + c] = bt; sm[128 + c] = egc_; sm[192 + c] = expf(gl - gc); sm[256 + c] = bt; sm[320 + c] = bt * egc_;
    }
    __syncthreads();
    {
#pragma unroll
      for (int k = 0; k < 2; ++k) {
        const int jt = 2 * wh + k;
        f32x4 dk = mma_nt64(hb + LKB, hb + LKB, wq * 16, jt * 16, fr, fq, f32x4{0.f, 0.f, 0.f, 0.f});
        int s = jt * 16 + fr;
        float gs = sm[s];
#pragma unroll
        for (int r = 0; r < 4; ++r) {
          int c = wq * 16 + fq * 4 + r;
          float v = s < c ? sm[64 + c] * dk[r] * __expf(sm[c] - gs) : 0.f;
          *(float*)(hb + LA + (s * 64 + (c & 3) * 16 + (c >> 2)) * 4) = v;
        }
      }
#pragma unroll
      for (int k = 0; k < 2; ++k) {
        const int it = 2 * wh + k;
        f32x4 dq = mma_nt64(hb + LKB, hb + LQS, it * 16, wq * 16, fr, fq, f32x4{0.f, 0.f, 0.f, 0.f});
        int c = wq * 16 + fr;
        float gcc = sm[c];
        float v[4];
#pragma unroll
        for (int r = 0; r < 4; ++r) {
          int s = it * 16 + fq * 4 + r;
          v[r] = s <= c ? dq[r] * __expf(gcc - sm[s]) : 0.f;
        }
        u32x2 o; o.x = pack2(v[0], v[1]); o.y = pack2(v[2], v[3]);
        *(u32x2*)(hb + LQK + c * 144 + (it * 16 + fq * 4) * 2) = o;
      }
    }
    __syncthreads();
    if (n + 1 < N) dn_prefetch(QK, VV, GB, base, hf ? N - 2 - n : n + 1, hf, h, tid, zr, gad, gab);
    {
      const int d = lane;
#pragma unroll
      for (int i = 0; i < 8; i += 2) {
        int c = lw * 8 + i;
        float k0 = bf2f(*(const u16*)(hb + LKB + c * 144 + d * 2)) * sm[192 + c];
        float k1 = bf2f(*(const u16*)(hb + LKB + (c + 1) * 144 + d * 2)) * sm[192 + c + 1];
        *(unsigned*)(hb + LKG + d * 144 + c * 2) = pack2(k0, k1);
      }
    }
    float xp[16];
    const int sj = tid >> 2, par = tid & 3;
    {
      const float* ATb = (const float*)(hb + LA) + par * 16;
      const char* rsrc = (sj < 64) ? hb + LVB + sj * 2 : hb + LKB + (sj - 64) * 2;
      const float* rs = sm + (sj < 64 ? 256 : 320);
#pragma unroll
      for (int i = 0; i < 16; ++i) xp[i] = rs[4 * i + par] * bf2f(*(const u16*)(rsrc + (4 * i + par) * 144));
#define DN_LOADA(dst, s_) _Pragma("unroll") for (int q = (((s_) >> 2) >> 2); q < 4; ++q) dst[q] = *(const float4*)(ATb + (s_) * 64 + q * 4)
#define DN_STEP(s_, Aq) do { const float xs_ = quad_bcast(xp[(s_) >> 2], (s_)); const f32x2 xs2_ = {xs_, xs_}; \
        _Pragma("unroll") for (int q = (((s_) >> 2) >> 2); q < 4; ++q) { \
          f32x2 lo_ = {xp[4 * q], xp[4 * q + 1]}, hi_ = {xp[4 * q + 2], xp[4 * q + 3]}; \
          const f32x2 al_ = {Aq[q].x, Aq[q].y}, ah_ = {Aq[q].z, Aq[q].w}; \
          lo_ = __builtin_elementwise_fma(-al_, xs2_, lo_); hi_ = __builtin_elementwise_fma(-ah_, xs2_, hi_); \
          xp[4 * q] = lo_[0]; xp[4 * q + 1] = lo_[1]; xp[4 * q + 2] = hi_[0]; xp[4 * q + 3] = hi_[1]; } } while (0)
      float4 A0[4], A1[4], A2[4], A3[4];
      DN_LOADA(A0, 0); DN_LOADA(A1, 1);
#pragma unroll
      for (int s = 0; s < 60; s += 4) {
        DN_LOADA(A2, s + 2); DN_LOADA(A3, s + 3); __builtin_amdgcn_sched_barrier(0);
        DN_STEP(s, A0); DN_STEP(s + 1, A1); __builtin_amdgcn_sched_barrier(0);
        DN_LOADA(A0, s + 4); DN_LOADA(A1, s + 5); __builtin_amdgcn_sched_barrier(0);
        DN_STEP(s + 2, A2); DN_STEP(s + 3, A3); __builtin_amdgcn_sched_barrier(0);
      }
      DN_LOADA(A2, 62); __builtin_amdgcn_sched_barrier(0);
      DN_STEP(60, A0); DN_STEP(61, A1); DN_STEP(62, A2);
    }
    if (sj < 64) {
#pragma unroll
      for (int i = 0; i < 16; ++i) *(u16*)(hb + LU2 + sj * 144 + (4 * i + par) * 2) = f2bf(xp[i]);
    } else {
#pragma unroll
      for (int i = 0; i < 16; ++i) *(u16*)(hb + LW2 + (4 * i + par) * 144 + (sj - 64) * 2) = f2bf(xp[i]);
    }
    __syncthreads();
    {
#pragma unroll
      for (int k = 0; k < 2; ++k) {
        const int ct = 2 * wh + k;
        f32x4 dd = mma_nt64(hb + LW2, hb + LST, ct * 16, wq * 16, fr, fq, f32x4{0.f, 0.f, 0.f, 0.f});
        int e = wq * 16 + fr;
        u32x2 u0 = *(const u32x2*)(hb + LU2 + e * 144 + (ct * 16 + fq * 4) * 2);
        float v0 = __uint_as_float(u0.x << 16) - dd[0], v1 = __uint_as_float(u0.x & 0xffff0000u) - dd[1];
        float v2 = __uint_as_float(u0.y << 16) - dd[2], v3 = __uint_as_float(u0.y & 0xffff0000u) - dd[3];
        u32x2 o; o.x = pack2(v0, v1); o.y = pack2(v2, v3);
        *(u32x2*)(hb + LA + e * 144 + (ct * 16 + fq * 4) * 2) = o;
      }
    }
    __syncthreads();
    {
      const int c = wq * 16 + fr;
      const float egc = sm[128 + c];
      const int tk = base + mch * 64 + (hf ? 63 - c : c);
#pragma unroll
      for (int k = 0; k < 2; ++k) {
        const int et = 2 * wh + k;
        f32x4 o = mma_nt64(hb + LST, hb + LQS, et * 16, wq * 16, fr, fq, f32x4{0.f, 0.f, 0.f, 0.f});
        o *= egc;
        o = mma_nt64(hb + LA, hb + LQK, et * 16, wq * 16, fr, fq, o);
        { u32x2 ov; ov.x = pack2(o[0], o[1]); ov.y = pack2(o[2], o[3]); *(u32x2*)(OB + (size_t)tk * 512 + h * 64 + et * 16 + fq * 4) = ov; }
      }
      const float egl = sm[128 + 63];
#pragma unroll
      for (int k = 0; k < 2; ++k) {
        const int dt = 2 * wh + k;
        sacc[k] *= egl;
        sacc[k] = mma_nt64(hb + LKG, hb + LA, dt * 16, wq * 16, fr, fq, sacc[k]);
      }
    }
    __syncthreads();
#pragma unroll
    for (int k = 0; k < 2; ++k) {
      const int dt = 2 * wh + k;
      u32x2 o; o.x = pack2(sacc[k][0], sacc[k][1]); o.y = pack2(sacc[k][2], sacc[k][3]);
      *(u32x2*)(hb + LST + (wq * 16 + fr) * 144 + (dt * 16 + fq * 4) * 2) = o;
    }
  }
  if (!sample) {
    const int tid = ltid(wv), lw = tid >> 6, lane = tid & 63, fr = lane & 15, fq = lane >> 4;
    float* so = p.out + OUT_S + (((size_t)seq * 2 + hf) * 8 + h) * 4096;
#pragma unroll
    for (int k = 0; k < 2; ++k)
#pragma unroll
      for (int r = 0; r < 4; ++r) so[((2 * (lw >> 2) + k) * 16 + fq * 4 + r) * 64 + (lw & 3) * 16 + fr] = sacc[k][r];
  }
  __syncthreads();
}

DI f32x16 mma32(bf16x8 a, bf16x8 b, f32x16 c) { return __builtin_amdgcn_mfma_f32_32x32x16_bf16(a, b, c, 0, 0, 0); }

DI void attn_item(const P& p, int item, int wv) {
  const int tid = ltid(wv), wid = tid >> 6, lane = tid & 63, r = lane & 31, h = lane >> 5;
  int b, head, qb, nk, tokbase;
  const u16* Kg; const u16* Vg;
  if (item < 64) {
    b = item >> 4; head = (item >> 2) & 3; qb = item & 3; nk = 1280; tokbase = T_P + b * 1024 + qb * 256;
    Kg = (const u16*)(p.ws + OFF_KS) + (size_t)b * 1280 * 512 + head * 128;
    Vg = (const u16*)(p.ws + OFF_VTS) + (size_t)b * 1280 * 512 + head * 128;
  } else {
    int id = item - 64; b = id >> 2; head = id & 3; qb = 0; nk = 256; tokbase = b * 256;
    Kg = (const u16*)(p.ws + OFF_KP) + (size_t)b * 256 * 512 + head * 128;
    Vg = (const u16*)(p.ws + OFF_VTP) + (size_t)b * 256 * 512 + head * 128;
  }
  float s1 = wave_sum(p.lq1[lane] * p.lk1[lane]);
  float s2 = wave_sum(p.lq2[lane] * p.lk2[lane]);
  const float lam = expf(s1) - expf(s2) + 0.2f;
  const int tq = tokbase + wid * 32 + r;
  const u16* Qg = (const u16*)(p.ws + OFF_Q) + (size_t)tq * 512 + head * 128;
  bf16x8 q[2][4];
#pragma unroll
  for (int mp = 0; mp < 2; ++mp)
#pragma unroll
    for (int ks = 0; ks < 4; ++ks) q[mp][ks] = *(const bf16x8*)(Qg + mp * 64 + ks * 16 + 8 * h);
  const int ntile = nk >> 6;
  float m0 = -1e30f, m1 = -1e30f, l0 = 0.f, l1 = 0.f;
  u32x4 kr[2], vr[2] = {};
  {
#pragma unroll
    for (int i = 0; i < 2; ++i) { int id = tid + 512 * i; int row = id >> 4, cp = id & 15;
      kr[i] = *(const u32x4*)(Kg + (size_t)row * 512 + cp * 8); }
  }
  __syncthreads();
  for (int t = 0; t < ntile; ++t) {
    char* KT = dsm + (t & 1) * 36864;
#pragma unroll
    for (int i = 0; i < 2; ++i) { int id = tid + 512 * i; int row = id >> 4, cp = id & 15;
      *(u32x4*)(KT + row * 272 + cp * 16) = kr[i]; }
    __syncthreads();
    if (t + 1 < ntile) {
#pragma unroll
      for (int i = 0; i < 2; ++i) { int id = tid + 512 * i; int row = id >> 4, cp = id & 15;
        kr[i] = *(const u32x4*)(Kg + (size_t)((t + 1) * 64 + row) * 512 + cp * 8); }
    } else {
#pragma unroll
      for (int i = 0; i < 2; ++i) { int id = tid + 512 * i; int row = id >> 4, cp = id & 15;
        kr[i] = *(const u32x4*)(Kg + (size_t)row * 512 + cp * 8);
        int vkey = id & 63, vcp = id >> 6;
        vr[i] = *(const u32x4*)(Vg + (size_t)vkey * 512 + vcp * 8); }
    }
#pragma unroll
    for (int kb2 = 0; kb2 < 2; ++kb2) {
      f32x16 sa = {}, sb = {};
#pragma unroll
      for (int ks = 0; ks < 4; ++ks) {
        bf16x8 a0 = *(const bf16x8*)(KT + (kb2 * 32 + r) * 272 + (ks * 16 + 8 * h) * 2);
        bf16x8 a1 = *(const bf16x8*)(KT + (kb2 * 32 + r) * 272 + (64 + ks * 16 + 8 * h) * 2);
        sa = mma32(a0, q[0][ks], sa); sb = mma32(a1, q[1][ks], sb);
      }
      float mx0 = sa[0], mx1 = sb[0];
#pragma unroll
      for (int i = 1; i < 16; ++i) { mx0 = fmaxf(mx0, sa[i]); mx1 = fmaxf(mx1, sb[i]); }
      float n0 = fmaxf(m0, mx0), n1 = fmaxf(m1, mx1);
      f32x2 acc0 = {0.f, 0.f}, acc1 = {0.f, 0.f};
      const f32x2 nn0 = {n0, n0}, nn1 = {n1, n1};
#pragma unroll
      for (int i = 0; i < 16; i += 2) {
        f32x2 d0 = f32x2{sa[i], sa[i + 1]} - nn0, d1 = f32x2{sb[i], sb[i + 1]} - nn1;
        acc0 += f32x2{__builtin_amdgcn_exp2f(d0[0]), __builtin_amdgcn_exp2f(d0[1])};
        acc1 += f32x2{__builtin_amdgcn_exp2f(d1[0]), __builtin_amdgcn_exp2f(d1[1])};
      }
      const float a0 = acc0[0] + acc0[1], a1 = acc1[0] + acc1[1];
      l0 = l0 * __builtin_amdgcn_exp2f(m0 - n0) + a0; l1 = l1 * __builtin_amdgcn_exp2f(m1 - n1) + a1;
      m0 = n0; m1 = n1;
    }
  }
  {
    float mo0 = __shfl_xor(m0, 32), lo0 = __shfl_xor(l0, 32), mo1 = __shfl_xor(m1, 32), lo1 = __shfl_xor(l1, 32);
    float M0 = fmaxf(m0, mo0), M1 = fmaxf(m1, mo1);
    l0 = l0 * __builtin_amdgcn_exp2f(m0 - M0) + lo0 * __builtin_amdgcn_exp2f(mo0 - M0);
    l1 = l1 * __builtin_amdgcn_exp2f(m1 - M1) + lo1 * __builtin_amdgcn_exp2f(mo1 - M1);
    m0 = M0; m1 = M1;
  }
  const float f0 = m0 + __log2f(l0);
  const float f1 = m1 + __log2f(l1) - __log2f(fmaxf(fabsf(lam), 1e-30f));
  const float sg = lam < 0.f ? -1.f : 1.f;
  f32x16 oacc[4] = {};
  __syncthreads();
  for (int t = 0; t < ntile; ++t) {
    char* KT = dsm + (t & 1) * 36864;
    char* VT = KT + 17408;
#pragma unroll
    for (int i = 0; i < 2; ++i) { int id = tid + 512 * i; int row = id >> 4, cp = id & 15;
      *(u32x4*)(KT + row * 272 + cp * 16) = kr[i];
      int vkey = id & 63, vcp = id >> 6;
      const unsigned vw[4] = {vr[i].x, vr[i].y, vr[i].z, vr[i].w};
#pragma unroll
      for (int j = 0; j < 4; ++j) {
        *(u16*)(VT + (vcp * 8 + 2 * j) * 144 + vkey * 2) = (u16)(vw[j] & 0xffffu);
        *(u16*)(VT + (vcp * 8 + 2 * j + 1) * 144 + vkey * 2) = (u16)(vw[j] >> 16);
      } }
    __syncthreads();
    if (t + 1 < ntile) {
#pragma unroll
      for (int i = 0; i < 2; ++i) { int id = tid + 512 * i; int row = id >> 4, cp = id & 15;
        kr[i] = *(const u32x4*)(Kg + (size_t)((t + 1) * 64 + row) * 512 + cp * 8);
        int vkey = id & 63, vcp = id >> 6;
        vr[i] = *(const u32x4*)(Vg + (size_t)((t + 1) * 64 + vkey) * 512 + vcp * 8); }
    }
#pragma unroll
    for (int kb2 = 0; kb2 < 2; ++kb2) {
      f32x16 sa = {}, sb = {};
#pragma unroll
      for (int ks = 0; ks < 4; ++ks) {
        bf16x8 a0 = *(const bf16x8*)(KT + (kb2 * 32 + r) * 272 + (ks * 16 + 8 * h) * 2);
        bf16x8 a1 = *(const bf16x8*)(KT + (kb2 * 32 + r) * 272 + (64 + ks * 16 + 8 * h) * 2);
        sa = mma32(a0, q[0][ks], sa); sb = mma32(a1, q[1][ks], sb);
      }
      float av[16];
      {
        const f32x2 ff0 = {f0, f0}, ff1 = {f1, f1}, nsg = {-sg, -sg};
#pragma unroll
        for (int i = 0; i < 16; i += 2) {
          f32x2 d0 = f32x2{sa[i], sa[i + 1]} - ff0, d1 = f32x2{sb[i], sb[i + 1]} - ff1;
          f32x2 e0 = {__builtin_amdgcn_exp2f(d0[0]), __builtin_amdgcn_exp2f(d0[1])};
          f32x2 e1 = {__builtin_amdgcn_exp2f(d1[0]), __builtin_amdgcn_exp2f(d1[1])};
          f32x2 r = __builtin_elementwise_fma(nsg, e1, e0);
          av[i] = r[0]; av[i + 1] = r[1];
        }
      }
#pragma unroll
      for (int s = 0; s < 2; ++s) {
        u32x4 pp;
        pp.x = pack2(av[8 * s], av[8 * s + 1]); pp.y = pack2(av[8 * s + 2], av[8 * s + 3]);
        pp.z = pack2(av[8 * s + 4], av[8 * s + 5]); pp.w = pack2(av[8 * s + 6], av[8 * s + 7]);
        bf16x8 pb = __builtin_bit_cast(bf16x8, pp);
#pragma unroll
        for (int dvb = 0; dvb < 4; ++dvb) {
          const char* vp = VT + (dvb * 32 + r) * 144 + (kb2 * 32 + 16 * s + 4 * h) * 2;
          u32x2 lo = *(const u32x2*)(vp), hi = *(const u32x2*)(vp + 16);
          u32x4 vv; vv.x = lo.x; vv.y = lo.y; vv.z = hi.x; vv.w = hi.y;
          oacc[dvb] = mma32(__builtin_bit_cast(bf16x8, vv), pb, oacc[dvb]);
        }
      }
    }
  }
  float ss = 0.f;
#pragma unroll
  for (int dvb = 0; dvb < 4; ++dvb)
#pragma unroll
    for (int i = 0; i < 16; ++i) ss += oacc[dvb][i] * oacc[dvb][i];
  ss += __shfl_xor(ss, 32);
  const float rstd = rsqrtf(ss * (1.f / 128.f) + 1e-6f) * 0.8f;
  u16* MIX = (u16*)(p.ws + OFF_MIX) + (size_t)tq * 1024 + 512 + head * 128;
#pragma unroll
  for (int dvb = 0; dvb < 4; ++dvb)
#pragma unroll
    for (int g = 0; g < 4; ++g) {
      int dv = dvb * 32 + 8 * g + 4 * h;
      float4 dn = *(const float4*)(p.diff_norm + dv);
      u32x2 o;
      o.x = pack2(oacc[dvb][4 * g] * rstd * dn.x, oacc[dvb][4 * g + 1] * rstd * dn.y);
      o.y = pack2(oacc[dvb][4 * g + 2] * rstd * dn.z, oacc[dvb][4 * g + 3] * rstd * dn.w);
      *(u32x2*)(MIX + dv) = o;
    }
  __syncthreads();
}

DI void mixer_phase(CP pp, int wv, int rep) {
  const P p = ldp(pp);
  int* ctr = (int*)(p.ws + OFF_CTR) + rep;
  int* cur = (int*)(dsm + LDS_BYTES - 16);
  while (true) {
    __syncthreads();
    if (ltid(wv) == 0) *cur = atomicAdd(ctr, 1);
    __syncthreads();
    int it = *cur;
    __syncthreads();
    if (it >= 768 + 592) break;
    if (it >= 768) {
      const int id = it - 768;
      if (id < 64) transpose_tile(p.w_out, 1024, (u16*)(p.ws + OFF_WB4), 1024, (id % 4) * 256, (id / 4) * 64, 0, wv);
      else if (id < 64 + 352) { const int j = id - 64; transpose_tile(p.w_ffn2_in, 5632, (u16*)(p.ws + OFF_WB5), 1024, (j % 22) * 256, (j / 22) * 64, 1, wv); }
      else { const int j = id - 416; transpose_tile(p.w_ffn2_out, 1024, (u16*)(p.ws + OFF_WB6), DFF, (j % 4) * 256, (j / 4) * 64, 0, wv); }
      continue;
    }
    if (it < 64) { for (int r2 = 0; r2 < DN_REP; ++r2) deltanet_item(p, 512 + it, wv); }
    else if (it < 128) { for (int r2 = 0; r2 < AT_REP; ++r2) attn_item(p, it - 64, wv); }
    else if (it < 640) { for (int r2 = 0; r2 < DN_REP; ++r2) deltanet_item(p, it - 128, wv); }
    else { for (int r2 = 0; r2 < AT_REP; ++r2) attn_item(p, it - 640 + 64, wv); }
  }
}

DI void combine_phase(CP pp, int wv) {
  const P p = ldp(pp);
  const int tidc = ltid(wv), lane = tidc & 63, wid = tidc >> 6;
  const u16* OB = (const u16*)(p.ws + OFF_HID);
  const u16* ZA = (const u16*)(p.ws + OFF_ZA);
  u16* MIX = (u16*)(p.ws + OFF_MIX);
  const int e0 = (lane & 7) * 8;
  const float4 dn0 = *(const float4*)(p.delta_norm + e0), dn1 = *(const float4*)(p.delta_norm + e0 + 4);
  for (int w = blockIdx.x * 8 + wid; w < 2048; w += gridDim.x * 8)
  for (int half = 0; half < 1; ++half) {
    u32x4 a[6][2]; u32x4 z[6];
#pragma unroll
    for (int rr = 0; rr < 6; ++rr) {
      const int t = w * 6 + rr;
      const size_t idx = (size_t)t * 512 + lane * 8;
      a[rr][0] = *(const u32x4*)(OB + idx);
      a[rr][1] = *(const u32x4*)(OB + (size_t)T_TOK * 512 + idx);
      z[rr] = *(const u32x4*)(ZA + (size_t)t * 2048 + 1536 + lane * 8);
    }
#pragma unroll
    for (int rr = 0; rr < 6; ++rr) {
      const int t = w * 6 + rr;
      float o[8];
      {
        const unsigned fa[4] = {a[rr][0].x, a[rr][0].y, a[rr][0].z, a[rr][0].w}, fb[4] = {a[rr][1].x, a[rr][1].y, a[rr][1].z, a[rr][1].w};
#pragma unroll
        for (int i = 0; i < 4; ++i) {
          o[2 * i] = __uint_as_float(fa[i] << 16) + __uint_as_float(fb[i] << 16);
          o[2 * i + 1] = __uint_as_float(fa[i] & 0xffff0000u) + __uint_as_float(fb[i] & 0xffff0000u);
        }
      }
      float ss = 0.f;
#pragma unroll
      for (int i = 0; i < 8; ++i) ss += o[i] * o[i];
      ss = oct_sum(ss);
      const float rstd = rsqrtf(ss * (1.f / 64.f) + 1e-6f);
      const float dnv[8] = {dn0.x, dn0.y, dn0.z, dn0.w, dn1.x, dn1.y, dn1.z, dn1.w};
      const unsigned zz[4] = {z[rr].x, z[rr].y, z[rr].z, z[rr].w};
      float y[8];
#pragma unroll
      for (int i = 0; i < 8; ++i) {
        float zv = (i & 1) ? __uint_as_float(zz[i >> 1] & 0xffff0000u) : __uint_as_float(zz[i >> 1] << 16);
        y[i] = o[i] * rstd * dnv[i] * siluf(zv);
      }
      u32x4 r; r.x = pack2(y[0], y[1]); r.y = pack2(y[2], y[3]); r.z = pack2(y[4], y[5]); r.w = pack2(y[6], y[7]);
      *(u32x4*)(MIX + (size_t)t * 1024 + lane * 8) = r;
    }
  }
}

DI void deferred_w23(CP pp, int wv) {
  const P p = ldp(pp);
  const int ntiles = 48 * 22, rem = ntiles % (int)gridDim.x;
  int first, stride;
  if (rem == 0) { first = blockIdx.x; stride = gridDim.x; }
  else { if ((int)blockIdx.x < rem) return; first = blockIdx.x - rem; stride = gridDim.x - rem; }
  for (int id = first; id < 176 + 240; id += stride) {
    if (id < 176) transpose_tile(p.w_ffn1_out, 1024, (u16*)(p.ws + OFF_WB2), DFF, (id % 4) * 256, (id / 4) * 64, 0, wv);
    else { const int j = id - 176; transpose_tile(p.w_in, 3616, (u16*)(p.ws + OFF_WB3), 1024, (j % 15) * 256, (j / 15) * 64, 2, wv); }
  }
  phase0(pp, wv, first, stride);
}

DI void gemm_dispatch(CP pp, int wv, int which) {
  const P p = ldp(pp);
  const u16* XN = (const u16*)(p.ws + OFF_XN);
  u16* HID = (u16*)(p.ws + OFF_HID);
  const float* MOD = (const float*)(p.ws + OFF_MOD);
  float* Y = p.out + OUT_Y;
  switch (which) {
    case 2: gemm_phase<4>(XN, (const u16*)(p.ws + OFF_WB1), 1024, 48, 22, EpiSwiGLU{HID}, wv); break;
    case 3: gemm_phase<3>(HID, (const u16*)(p.ws + OFF_WB2), DFF, 64, 4, EpiResid192{p.x_prompt, p.x_sample, Y, MOD, 2, 0.5f}, wv); break;
    case 5: gemm_phase<4>(XN, (const u16*)(p.ws + OFF_WB3), 1024, 48, 15, EpiInProj{p.ws, p.out}, wv); break;
    case 8: gemm_phase<3>((const u16*)(p.ws + OFF_MIX), (const u16*)(p.ws + OFF_WB4), 1024, 64, 4, EpiResid192{Y, Y + (size_t)T_P * 1024, Y, MOD, 5, 1.0f}, wv); break;
    case 10: gemm_phase<4>(XN, (const u16*)(p.ws + OFF_WB5), 1024, 48, 22, EpiSwiGLU{HID}, wv); break;
    case 11: gemm_phase<3>(HID, (const u16*)(p.ws + OFF_WB6), DFF, 64, 4, EpiResid192{Y, Y + (size_t)T_P * 1024, Y, MOD, 8, 0.5f}, wv); break;
  }
}

__global__ void __launch_bounds__(512, 2) mega(P pv) {
  cg::grid_group grid = cg::this_grid();
  CP pp = (CP)__builtin_amdgcn_kernarg_segment_ptr();
  const int wv = __builtin_amdgcn_readfirstlane(threadIdx.x >> 6);
  const int plo = pp->plo, phi = pp->phi;
  if (phi > 1000) grid.sync();
  gbar_post(pp, wv);
#ifdef EXTRA_SYNCS
  for (int i = 0; i < EXTRA_SYNCS; ++i) gbar(pp, wv);
#endif
  for (int ph = plo; ph <= phi; ++ph) {
    const int reps = ((REPEAT_MASK >> ph) & 1) ? 2 : 1;
    for (int rep = 0; rep < reps; ++rep) {
    if (ph > plo || rep > 0) gbar(pp, wv);
    switch (ph) {
      case 0: phase0(pp, wv); break;
      case 1: norm_phase<0>(pp, wv); break;
      case 4: norm_phase<1>(pp, wv); break;
      case 6: conv_phase(pp, wv); gbar(pp, wv); mixer_phase(pp, wv, rep); break;
      case 7: combine_phase(pp, wv); break;
      case 9: norm_phase<2>(pp, wv); break;
      case 12: norm_phase<3>(pp, wv); break;
      default: gemm_dispatch(pp, wv, ph); if (ph == 2 && rep == 0) deferred_w23(pp, wv); break;
    }
    }
  }
}

extern "C" void kernel_launch(void* const* d_in, const int* in_sizes, int n_in, void* d_out, int out_size,
                              void* d_ws, size_t ws_size, hipStream_t stream) {
  static int grid_blocks = 0;
  if (!grid_blocks) {
    int dev = 0, cus = 0, per_cu = 0;
    hipGetDevice(&dev);
    hipDeviceGetAttribute(&cus, hipDeviceAttributeMultiprocessorCount, dev);
    hipFuncSetAttribute((const void*)mega, hipFuncAttributeMaxDynamicSharedMemorySize, LDS_BYTES);
    hipOccupancyMaxActiveBlocksPerMultiprocessor(&per_cu, (const void*)mega, 512, LDS_BYTES);
    if (per_cu < 1) per_cu = 1;
    grid_blocks = cus * per_cu;
    if (grid_blocks > 256) grid_blocks = 256;
    grid_blocks &= ~7;
    if (ws_size < WS_END) fprintf(stderr, "workspace too small: %zu < %zu\n", ws_size, (size_t)WS_END);
  }
  hipMemsetAsync((char*)d_ws + OFF_BAR, 0, 16384, stream);
  P p{};
  const float** f = (const float**)&p;
  for (int i = 0; i < 28; ++i) f[i] = (const float*)d_in[i];
  p.out = (float*)d_out; p.ws = (char*)d_ws;
#if MK_MULTI
  for (int ph = 0; ph <= 12; ++ph) {
    p.plo = ph; p.phi = ph;
    hipLaunchKernelGGL(mega, dim3(grid_blocks), dim3(512), LDS_BYTES, stream, p);
  }
#else
  p.plo = 0; p.phi = 12;
  void* args[] = {&p};
  hipError_t e = hipLaunchCooperativeKernel((const void*)mega, dim3(grid_blocks), dim3(512), args, LDS_BYTES, stream);
  if (e != hipSuccess) fprintf(stderr, "cooperative launch failed: %s (grid %d)\n", hipGetErrorString(e), grid_blocks);
#endif
}
```
